# Optimizing an MI355X kernel written in HIP

```python
import math
import jax, jax.numpy as jnp
from jax import lax
import numpy as np

D_MODEL = 1024
BATCH = 2
SEQ = 8192
DEPTH = 1

N_HEADS = 8
HEAD_DIM = 64
ATT_WIDTH = N_HEADS * HEAD_DIM
LRU_WIDTH = 1024
LRU_BLOCKS = 8
LRU_BLOCK_DIM = LRU_WIDTH // LRU_BLOCKS
LRU_C = 8.0
CONV_WIDTH = 4
IN_PROJ = 3 * ATT_WIDTH + 2 * LRU_WIDTH
PL_DIM = 256
N_EXPERTS = 32
TOP_K = 4
D_EXPERT = 1024
SWIGLU_LIMIT = 7.0
SWIGLU_ALPHA = 1.702
Q_BLOCK = 128
MOE_BLOCK = 128
EPS = 1e-6

kernel_name = "hybrid_stickbreak_rglru_moe_block"


def rmsnorm(x, g):
    x32 = x.astype(jnp.float32)
    y = x32 * lax.rsqrt(jnp.mean(x32 * x32, axis=-1, keepdims=True) + EPS) * g.astype(jnp.float32)
    return y.astype(x.dtype)


def stick_breaking_attention(q, k, v):
    B, S, _ = q.shape
    n_qb = S // Q_BLOCK
    qh = q.reshape(B, S, N_HEADS, HEAD_DIM).astype(jnp.float32) * (1.0 / math.sqrt(HEAD_DIM))
    kh = k.reshape(B, S, N_HEADS, HEAD_DIM).astype(jnp.float32)
    vh = v.reshape(B, S, N_HEADS, HEAD_DIM).astype(jnp.float32)
    qb = qh.reshape(B, n_qb, Q_BLOCK, N_HEADS, HEAD_DIM).transpose(1, 0, 3, 2, 4)
    kpos = jnp.arange(S)

    def block(args):
        q_blk, blk = args
        qpos = blk * Q_BLOCK + jnp.arange(Q_BLOCK)
        z = jnp.einsum('bhqd,bkhd->bhqk', q_blk, kh)
        mask = kpos[None, :] < qpos[:, None]
        log_keep = jnp.where(mask, jax.nn.log_sigmoid(-z), 0.0)
        log_between = lax.cumsum(log_keep, axis=3, reverse=True) - log_keep
        w = jnp.where(mask, jnp.exp(jax.nn.log_sigmoid(z) + log_between), 0.0)
        return jnp.einsum('bhqk,bkhd->bqhd', w, vh)

    out = lax.map(block, (qb, jnp.arange(n_qb)))
    return out.transpose(1, 0, 2, 3, 4).reshape(B, S, ATT_WIDTH).astype(q.dtype)


def causal_depthwise_conv(u, w, b):
    S = u.shape[1]
    up = jnp.pad(u, ((0, 0), (CONV_WIDTH - 1, 0), (0, 0)))
    out = b
    for j in range(CONV_WIDTH):
        out = out + up[:, j:j + S] * w[j]
    return out


def rglru(u, wa, ba, wx, bx, lam):
    B, S, W = u.shape
    ub = u.reshape(B, S, LRU_BLOCKS, LRU_BLOCK_DIM)
    r = jax.nn.sigmoid(jnp.einsum('bsnc,ncd->bsnd', ub, wa).reshape(B, S, W) + ba)
    i = jax.nn.sigmoid(jnp.einsum('bsnc,ncd->bsnd', ub, wx).reshape(B, S, W) + bx)
    log_a = LRU_C * r.astype(jnp.float32) * jax.nn.log_sigmoid(lam.astype(jnp.float32))
    a = jnp.exp(log_a)
    b_in = jnp.sqrt(-jnp.expm1(2.0 * log_a)) * (i * u).astype(jnp.float32)

    def step(h, ab):
        a_t, b_t = ab
        h = a_t * h + b_t
        return h, h

    _, hs = lax.scan(step, jnp.zeros((B, W), jnp.float32),
                     (a.transpose(1, 0, 2), b_in.transpose(1, 0, 2)))
    return hs.transpose(1, 0, 2).astype(u.dtype)


def token_mixing(xn, w_in, conv_w, conv_b, lru_wa, lru_ba, lru_wx, lru_bx, lru_lambda,
                 w_att_out, w_lru_out, w_merge, b_merge, w_out):
    proj = xn @ w_in
    q, k, v, u, g_in = jnp.split(
        proj, [ATT_WIDTH, 2 * ATT_WIDTH, 3 * ATT_WIDTH, 3 * ATT_WIDTH + LRU_WIDTH], axis=-1)
    y_att = stick_breaking_attention(q, k, v) @ w_att_out
    h_lru = rglru(causal_depthwise_conv(u, conv_w, conv_b), lru_wa, lru_ba, lru_wx, lru_bx, lru_lambda)
    y_lru = (jax.nn.gelu(g_in) * h_lru) @ w_lru_out
    gates = jax.nn.sigmoid(xn @ w_merge + b_merge)
    g_att, g_lru = jnp.split(gates, 2, axis=-1)
    return (g_att * y_att + g_lru * y_lru) @ w_out


def clamped_swiglu_expert(xb, w_gu, b_gu, w_dn, b_dn):
    hgu = xb @ w_gu + b_gu
    gate, up = jnp.split(hgu, 2, axis=-1)
    gate = jnp.minimum(gate, SWIGLU_LIMIT)
    up = jnp.clip(up, -SWIGLU_LIMIT, SWIGLU_LIMIT)
    glu = gate * jax.nn.sigmoid(gate * SWIGLU_ALPHA)
    return ((up + 1.0) * glu) @ w_dn + b_dn


def moe(xn, w_router, b_router, w_gate_up, b_gate_up, w_down, b_down):
    B, S, D = xn.shape
    n_tok = B * S
    xf = xn.reshape(n_tok, D)
    logits = (xf @ w_router + b_router).astype(jnp.float32)
    top_v, top_e = lax.top_k(logits, TOP_K)
    gates = jax.nn.softmax(top_v, axis=-1)
    n_asg = n_tok * TOP_K
    e_flat = top_e.reshape(n_asg)
    tok_flat = jnp.arange(n_asg, dtype=jnp.int32) // TOP_K
    g_flat = gates.reshape(n_asg)
    order = jnp.argsort(e_flat)
    e_sorted, tok_sorted, g_sorted = e_flat[order], tok_flat[order], g_flat[order]
    counts = jnp.bincount(e_flat, length=N_EXPERTS)
    padded = (counts + MOE_BLOCK - 1) // MOE_BLOCK * MOE_BLOCK
    start = jnp.cumsum(counts) - counts
    pad_end = jnp.cumsum(padded)
    pad_start = pad_end - padded
    dest = pad_start[e_sorted] + jnp.arange(n_asg) - start[e_sorted]
    n_rows = (n_asg + MOE_BLOCK - 1) // MOE_BLOCK * MOE_BLOCK + N_EXPERTS * MOE_BLOCK
    n_blocks = n_rows // MOE_BLOCK
    row_tok = jnp.zeros((n_rows,), jnp.int32).at[dest].set(tok_sorted)
    row_gate = jnp.zeros((n_rows,), jnp.float32).at[dest].set(g_sorted)
    block_expert = jnp.minimum(
        jnp.searchsorted(pad_end, jnp.arange(n_blocks) * MOE_BLOCK, side='right'), N_EXPERTS - 1)
    xb = xf[row_tok].reshape(n_blocks, MOE_BLOCK, D)

    def expert_block(args):
        x_blk, e = args
        return clamped_swiglu_expert(x_blk, w_gate_up[e], b_gate_up[e], w_down[e], b_down[e])

    yb = lax.map(expert_block, (xb, block_expert))
    y_rows = yb.reshape(n_rows, D).astype(jnp.float32) * row_gate[:, None]
    y = jax.ops.segment_sum(y_rows, row_tok, num_segments=n_tok)
    return y.reshape(B, S, D).astype(xn.dtype)


def setup_inputs(seed: int = 0) -> dict:
    key = jax.random.key(seed)
    ks = jax.random.split(key, 32)

    def nrm(k, shape, scale):
        return jax.random.normal(k, shape, jnp.float32) * scale

    u = jax.random.uniform(ks[10], (DEPTH, LRU_WIDTH), jnp.float32, minval=0.9, maxval=0.999)
    a0 = u ** (1.0 / LRU_C)
    lru_lambda = jnp.log(a0) - jnp.log1p(-a0)
    return {
        "x": nrm(ks[0], (BATCH, SEQ, D_MODEL), 1.0),
        "p": nrm(ks[1], (DEPTH, BATCH, SEQ, PL_DIM), 1.0),
        "norm_mix_g": 1.0 + nrm(ks[2], (DEPTH, D_MODEL), 0.02),
        "w_in": nrm(ks[3], (DEPTH, D_MODEL, IN_PROJ), D_MODEL ** -0.5),
        "conv_w": nrm(ks[4], (DEPTH, CONV_WIDTH, LRU_WIDTH), CONV_WIDTH ** -0.5),
        "conv_b": nrm(ks[5], (DEPTH, LRU_WIDTH), 0.01),
        "lru_wa": nrm(ks[6], (DEPTH, LRU_BLOCKS, LRU_BLOCK_DIM, LRU_BLOCK_DIM), LRU_BLOCK_DIM ** -0.5),
        "lru_ba": nrm(ks[7], (DEPTH, LRU_WIDTH), 0.01),
        "lru_wx": nrm(ks[8], (DEPTH, LRU_BLOCKS, LRU_BLOCK_DIM, LRU_BLOCK_DIM), LRU_BLOCK_DIM ** -0.5),
        "lru_bx": nrm(ks[9], (DEPTH, LRU_WIDTH), 0.01),
        "lru_lambda": lru_lambda,
        "w_att_out": nrm(ks[11], (DEPTH, ATT_WIDTH, D_MODEL), ATT_WIDTH ** -0.5),
        "w_lru_out": nrm(ks[12], (DEPTH, LRU_WIDTH, D_MODEL), LRU_WIDTH ** -0.5),
        "w_merge": nrm(ks[13], (DEPTH, D_MODEL, 2 * D_MODEL), D_MODEL ** -0.5),
        "b_merge": nrm(ks[14], (DEPTH, 2 * D_MODEL), 0.01),
        "w_out": nrm(ks[15], (DEPTH, D_MODEL, D_MODEL), D_MODEL ** -0.5),
        "norm_moe_g": 1.0 + nrm(ks[16], (DEPTH, D_MODEL), 0.02),
        "w_router": nrm(ks[17], (DEPTH, D_MODEL, N_EXPERTS), D_MODEL ** -0.5),
        "b_router": nrm(ks[18], (DEPTH, N_EXPERTS), 0.01),
        "w_gate_up": nrm(ks[19], (DEPTH, N_EXPERTS, D_MODEL, 2 * D_EXPERT), D_MODEL ** -0.5),
        "b_gate_up": nrm(ks[20], (DEPTH, N_EXPERTS, 2 * D_EXPERT), 0.01),
        "w_down": nrm(ks[21], (DEPTH, N_EXPERTS, D_EXPERT, D_MODEL), D_EXPERT ** -0.5),
        "b_down": nrm(ks[22], (DEPTH, N_EXPERTS, D_MODEL), 0.01),
        "norm_pl_g": 1.0 + nrm(ks[23], (DEPTH, D_MODEL), 0.02),
        "w_pl_gate": nrm(ks[24], (DEPTH, D_MODEL, D_MODEL), D_MODEL ** -0.5),
        "b_pl_gate": nrm(ks[25], (DEPTH, D_MODEL), 0.01),
        "w_pl_proj": nrm(ks[26], (DEPTH, PL_DIM, D_MODEL), PL_DIM ** -0.5),
        "norm_pl_post_g": 1.0 + nrm(ks[27], (DEPTH, D_MODEL), 0.02),
        "norm_final_g": 1.0 + nrm(ks[28], (D_MODEL,), 0.02),
    }


def reference(x, p, norm_mix_g, w_in, conv_w, conv_b, lru_wa, lru_ba, lru_wx, lru_bx, lru_lambda,
              w_att_out, w_lru_out, w_merge, b_merge, w_out, norm_moe_g, w_router, b_router,
              w_gate_up, b_gate_up, w_down, b_down, norm_pl_g, w_pl_gate, b_pl_gate, w_pl_proj,
              norm_pl_post_g, norm_final_g):
    h = x
    for i in range(DEPTH):
        xn = rmsnorm(h, norm_mix_g[i])
        h = h + token_mixing(xn, w_in[i], conv_w[i], conv_b[i], lru_wa[i], lru_ba[i], lru_wx[i],
                             lru_bx[i], lru_lambda[i], w_att_out[i], w_lru_out[i], w_merge[i],
                             b_merge[i], w_out[i])
        xn = rmsnorm(h, norm_moe_g[i])
        h = h + moe(xn, w_router[i], b_router[i], w_gate_up[i], b_gate_up[i], w_down[i], b_down[i])
        hn = rmsnorm(h, norm_pl_g[i])
        pl_gate = jax.nn.sigmoid(hn @ w_pl_gate[i] + b_pl_gate[i])
        pl = rmsnorm(p[i].astype(h.dtype) @ w_pl_proj[i], norm_pl_post_g[i])
        h = h + pl_gate * pl
    return rmsnorm(h, norm_final_g)
```

```cpp
#include <hip/hip_runtime.h>
#include <cstdio>
#include <cstdint>

#ifndef MK_N_LAUNCHES
#define MK_N_LAUNCHES 12
#endif

#define GAS __attribute__((address_space(1)))
#define LAS __attribute__((address_space(3)))
typedef unsigned short bf16;
typedef unsigned v4u __attribute__((ext_vector_type(4)));
typedef float f32x4 __attribute__((ext_vector_type(4)));
typedef GAS unsigned gu32;
#define RLX_AGENT __ATOMIC_RELAXED, __HIP_MEMORY_SCOPE_AGENT
#define LDS_WAIT() asm volatile("s_waitcnt lgkmcnt(0)" ::: "memory")
#define VM_WAIT() asm volatile("s_waitcnt vmcnt(0)" ::: "memory")

constexpr int BATCH = 2, SEQ = 8192, D = 1024, M = BATCH * SEQ;
constexpr int NH = 8, HD = 64, AW = 512, LW = 1024, NPROJ = 3584, NGATE = 2048, NIN = NPROJ + NGATE;
constexpr int PLD = 256, NE = 32, TOPK = 4, DE = 1024;
constexpr int MOE_ROWS = M * TOPK + NE * 256;
constexpr float EPS = 1e-6f;
constexpr int NWAVES = 8, NTHREADS = 512;
constexpr int NPHASE = 13;

constexpr size_t MiB = 1u << 20;
constexpr size_t WS_CTL = 0, CTL_ZERO_BYTES = 1 * MiB;
constexpr size_t WS_WLRUA = 2 * MiB, WS_WLRUX = WS_WLRUA + 256 * 1024;
constexpr size_t WS_WATTO = 3 * MiB, WS_WLRUO = 4 * MiB, WS_WOUT = 6 * MiB, WS_WPLG = 8 * MiB, WS_WPLP = 10 * MiB;
constexpr size_t WS_WIN = 12 * MiB;
constexpr size_t WS_P16 = 24 * MiB;
constexpr size_t WS_WGU = 32 * MiB;
constexpr size_t WS_WDN = 160 * MiB;
constexpr size_t WS_XN = 224 * MiB;
constexpr size_t WS_PROJ = 256 * MiB;
constexpr size_t WS_PLRAW = 432 * MiB;
constexpr size_t WS_ATT = 464 * MiB;
constexpr size_t WS_HLOC = 480 * MiB, WS_PCUM = 512 * MiB, WS_YPRE = 544 * MiB;
constexpr size_t WS_Y1 = 576 * MiB;
constexpr size_t WS_MERGED = 640 * MiB;
constexpr size_t WS_HN = 672 * MiB;
constexpr size_t WS_YROWS = 704 * MiB;
constexpr size_t WS_SMALL = 848 * MiB;
constexpr size_t WS_HMOE = 856 * MiB;
constexpr size_t WS_END = 1000 * MiB;
constexpr size_t SM_TOKE = 0, SM_TOKSLOT = 256 * 1024, SM_TOKGATE = 512 * 1024, SM_LIST = 1 * MiB  , SM_PLSTAT = 3 * MiB  ;
constexpr int CW_TMO = 0, CW_CODE = 1, CW_COUNTS = 64  , CW_BAR = 4096;

__device__ __forceinline__ float bf2f(bf16 v) { return __uint_as_float(((unsigned)v) << 16); }
__device__ __forceinline__ unsigned f2bf(float f) { unsigned u = __builtin_bit_cast(unsigned, f); return (u + 0x7fffu + ((u >> 16) & 1u)) >> 16; }
__device__ __forceinline__ unsigned pk2(float lo, float hi) { return f2bf(lo) | (f2bf(hi) << 16); }
__device__ __forceinline__ float sigmoidf_(float x) { return 1.0f / (1.0f + __expf(-x)); }
__device__ __forceinline__ float logsigf_(float x) { return fminf(x, 0.f) - log1pf(__expf(-fabsf(x))); }
__device__ __forceinline__ float gelu_tanh(float x) { const float u = 0.7978845608028654f * (x + 0.044715f * x * x * x); return 0.5f * x * (1.0f + tanhf(u)); }
__device__ __forceinline__ float wave_sum(float v) {
#pragma unroll
    for (int o = 1; o < 64; o <<= 1) v += __shfl_xor(v, o);
    return v;
}

#define XB_TMO      128
#define XB_XCNT(j)  (256  + 64 * (j))
#define XB_XSUB(j)  (1280 + 64 * (j))
#define XB_XGEN(j)  (2304 + 64 * (j))
#define XB_TOP      3328
#define XB_TOPGEN   3392
#define XCD_BAR_WORDS 3456
#define XB_SPIN_CAP (1u << 18)
__device__ __forceinline__ unsigned xb_ld(unsigned* p)              { return __hip_atomic_load(p, __ATOMIC_RELAXED, __HIP_MEMORY_SCOPE_AGENT); }
__device__ __forceinline__ unsigned xb_add(unsigned* p, unsigned v) { return __hip_atomic_fetch_add(p, v, __ATOMIC_RELAXED, __HIP_MEMORY_SCOPE_AGENT); }
__device__ __forceinline__ unsigned xb_xcc_id() { return (unsigned)__builtin_amdgcn_s_getreg((3 << 11) | 20) & 0xFu; }
#define XB_SPIN(cond, bar) do { unsigned _sp = 0; while (cond) { __builtin_amdgcn_s_sleep(1); \
    if ((++_sp & 255u) == 0u) { if (xb_ld(&(bar)[XB_TMO])) break; if (_sp > XB_SPIN_CAP) { atomicAdd(&(bar)[XB_TMO], 1u); break; } } } } while (0)
struct XcdBarrier { unsigned* bar; unsigned x; volatile LAS unsigned* st; };
__device__ __forceinline__ XcdBarrier xcd_barrier_post(unsigned* bar, volatile LAS unsigned* st) {
    XcdBarrier b; b.bar = bar; b.x = xb_xcc_id(); b.st = st;
    if (threadIdx.x == 0) (void)xb_add(&bar[XB_XCNT(b.x)], 1u);
    return b;
}
__device__ __forceinline__ void xcd_barrier_complete(unsigned* bar, unsigned x, unsigned& nloc, unsigned& nx) {
    const unsigned G = gridDim.x * gridDim.y * gridDim.z;
    unsigned sum, cnt, mine, sp = 0u;
    for (;;) {
        sum = 0u; cnt = 0u; mine = 0u;
#pragma unroll
        for (unsigned j = 0; j < 16; ++j) { const unsigned c = xb_ld(&bar[XB_XCNT(j)]); sum += c; cnt += (c > 0u) ? 1u : 0u; mine = (j == x) ? c : mine; }
        if (sum == G) break;
        __builtin_amdgcn_s_sleep(1);
        if ((++sp & 255u) == 0u) { if (xb_ld(&bar[XB_TMO])) break; if (sp > XB_SPIN_CAP) { atomicAdd(&bar[XB_TMO], 1u); break; } }
    }
    nloc = mine > 0u ? mine : 1u; nx = cnt > 0u ? cnt : 1u;
}
__device__ __forceinline__ void xcd_barrier(const XcdBarrier& b) {
    asm volatile("s_waitcnt vmcnt(0)" ::: "memory");
    __syncthreads();
    if (threadIdx.x == 0) {
        unsigned* bar = b.bar;
        __builtin_amdgcn_s_waitcnt(0);
        unsigned nloc = b.st[0], nx = b.st[1];
        if (nloc == 0u) { xcd_barrier_complete(bar, b.x, nloc, nx); b.st[0] = nloc; b.st[1] = nx; }
        const unsigned old = xb_add(&bar[XB_XSUB(b.x)], 1u);
        const unsigned gen = old / nloc;
        if (old + 1u == (gen + 1u) * nloc) {
            __builtin_amdgcn_fence(__ATOMIC_RELEASE, "agent");
            asm volatile("s_waitcnt vmcnt(0)" ::: "memory");
            const unsigned og = xb_add(&bar[XB_TOP], 1u);
            const unsigned tg = og / nx;
            if (og + 1u == (tg + 1u) * nx) xb_add(&bar[XB_TOPGEN], 1u);
            else XB_SPIN(xb_ld(&bar[XB_TOPGEN]) == tg, bar);
            __builtin_amdgcn_fence(__ATOMIC_ACQUIRE, "agent");
            xb_add(&bar[XB_XGEN(b.x)], 1u);
            asm volatile("s_waitcnt vmcnt(0)" ::: "memory");
        } else {
            XB_SPIN(xb_ld(&bar[XB_XGEN(b.x)]) == gen, bar);
            __builtin_amdgcn_fence(__ATOMIC_ACQUIRE, "agent");
            asm volatile("s_waitcnt vmcnt(0)" ::: "memory");
        }
    }
    __syncthreads();
}

constexpr int RING_BYTES = 131072, LDSCTL_OFF = RING_BYTES, MISC_OFF = LDSCTL_OFF + 320, LDS_BYTES = 147456;
struct Frame {
    LAS unsigned char* lds; volatile LAS unsigned* MISC; gu32* ctl;
    int tid, lane, wave, G, bid;
    const float* in[29]; float* out; unsigned char* ws;
};
#define WSP(T, off) ((T*)(F.ws + (off)))

constexpr int NG_AS = 132, NG_BS = 68;
template <bool DUAL, class ARow, class Epi>
__device__ __forceinline__ void ngemm_tile(LAS float* As, LAS float* Bs, LAS float* Bs2, const bf16* A, int lda, const ARow& arow,
                                           const bf16* Bt, int ldb, int brow0, int K, int tid, const Epi& epi) {
    const int ty = tid >> 4, tx = tid & 15;
    float acc[4][4], acc2[4][4];
#pragma unroll
    for (int i = 0; i < 4; ++i)
#pragma unroll
        for (int j = 0; j < 4; ++j) { acc[i][j] = 0.f; acc2[i][j] = 0.f; }
    const int lr = tid >> 2, lk = (tid & 3) * 8;
    const long ar = arow(lr);
    for (int k0 = 0; k0 < K; k0 += 32) {
        __syncthreads();
        {
            v4u v = (v4u){0u, 0u, 0u, 0u};
            if (ar >= 0) v = *(const v4u*)(A + (size_t)ar * lda + k0 + lk);
            const unsigned w[4] = {v.x, v.y, v.z, v.w};
#pragma unroll
            for (int j = 0; j < 4; ++j) { As[(lk + 2 * j) * NG_AS + lr] = __uint_as_float(w[j] << 16); As[(lk + 2 * j + 1) * NG_AS + lr] = __uint_as_float(w[j] & 0xffff0000u); }
        }
        if (tid < 256) {
            const v4u v = *(const v4u*)(Bt + (size_t)(brow0 + lr) * ldb + k0 + lk);
            const unsigned w[4] = {v.x, v.y, v.z, v.w};
#pragma unroll
            for (int j = 0; j < 4; ++j) { Bs[(lk + 2 * j) * NG_BS + lr] = __uint_as_float(w[j] << 16); Bs[(lk + 2 * j + 1) * NG_BS + lr] = __uint_as_float(w[j] & 0xffff0000u); }
        } else if (DUAL) {
            const int lr2 = lr - 64;
            const v4u v = *(const v4u*)(Bt + (size_t)(brow0 + 128 + lr2) * ldb + k0 + lk);
            const unsigned w[4] = {v.x, v.y, v.z, v.w};
#pragma unroll
            for (int j = 0; j < 4; ++j) { Bs2[(lk + 2 * j) * NG_BS + lr2] = __uint_as_float(w[j] << 16); Bs2[(lk + 2 * j + 1) * NG_BS + lr2] = __uint_as_float(w[j] & 0xffff0000u); }
        }
        __syncthreads();
#pragma unroll 8
        for (int k = 0; k < 32; ++k) {
            const f32x4 a = *(const LAS f32x4*)(As + k * NG_AS + ty * 4);
            const f32x4 b = *(const LAS f32x4*)(Bs + k * NG_BS + tx * 4);
#pragma unroll
            for (int i = 0; i < 4; ++i)
#pragma unroll
                for (int j = 0; j < 4; ++j) acc[i][j] += a[i] * b[j];
            if (DUAL) {
                const f32x4 b2 = *(const LAS f32x4*)(Bs2 + k * NG_BS + tx * 4);
#pragma unroll
                for (int i = 0; i < 4; ++i)
#pragma unroll
                    for (int j = 0; j < 4; ++j) acc2[i][j] += a[i] * b2[j];
            }
        }
    }
#pragma unroll
    for (int i = 0; i < 4; ++i)
#pragma unroll
        for (int j = 0; j < 4; ++j) epi(ty * 4 + i, tx * 4 + j, acc[i][j], acc2[i][j]);
}
#define NG_LDS(F) LAS float* As = (LAS float*)(F.lds); LAS float* Bs = As + 32 * NG_AS; LAS float* Bs2 = Bs + 32 * NG_BS;
struct ARowLin { long r0; __device__ __forceinline__ long operator()(int r) const { return r0 + r; } };

__device__ __forceinline__ void p0_transpose_item(const float* W, int K, int N, bf16* WT, long row_off, LAS float* scr, int kb, int nb, int lane) {
    const int k0 = 64 * kb, n0 = 32 * nb;
#pragma unroll 8
    for (int i = 0; i < 32; ++i) { const int kk = 2 * i + (lane >> 5); scr[kk * 33 + (lane & 31)] = W[(size_t)(k0 + kk) * N + n0 + (lane & 31)]; }
    LDS_WAIT(); asm volatile("" ::: "memory");
    const int c = lane & 7;
#pragma unroll
    for (int j = 0; j < 4; ++j) { const int n = (lane >> 3) + 8 * j; const LAS float* s = scr + (8 * c) * 33 + n;
        v4u o; o.x = pk2(s[0 * 33], s[1 * 33]); o.y = pk2(s[2 * 33], s[3 * 33]); o.z = pk2(s[4 * 33], s[5 * 33]); o.w = pk2(s[6 * 33], s[7 * 33]);
        *(GAS v4u*)(WT + (size_t)(row_off + n0 + n) * K + k0 + 8 * c) = o; }
    LDS_WAIT(); asm volatile("" ::: "memory");
}
__device__ __forceinline__ void rms_row_to_bf16(const float* xrow, const float* g, bf16* orow, int lane) {
    const GAS f32x4* xr = (const GAS f32x4*)xrow + lane; const GAS f32x4* gr = (const GAS f32x4*)g + lane;
    f32x4 v[4]; float s2 = 0.f;
#pragma unroll
    for (int j = 0; j < 4; ++j) { v[j] = xr[64 * j]; s2 += (v[j].x * v[j].x + v[j].y * v[j].y) + (v[j].z * v[j].z + v[j].w * v[j].w); }
    const float rstd = 1.f / sqrtf(wave_sum(s2) * (1.f / D) + EPS);
    GAS unsigned long long* o8 = (GAS unsigned long long*)orow + lane;
#pragma unroll
    for (int j = 0; j < 4; ++j) { const f32x4 gg = gr[64 * j];
        o8[64 * j] = (unsigned long long)pk2(v[j].x * rstd * gg.x, v[j].y * rstd * gg.y) | ((unsigned long long)pk2(v[j].z * rstd * gg.z, v[j].w * rstd * gg.w) << 32); }
}
__device__ __forceinline__ void p0_prologue(Frame& F) {
    LAS float* scr = (LAS float*)(F.lds + F.wave * 16384);
    const int gw = F.bid * NWAVES + F.wave, NGW = F.G * NWAVES;
    constexpr int I_IN = (D / 64) * (NPROJ / 32), I_MG = (D / 64) * (NGATE / 32), I_LR = 8 * 2 * 4  ;
    constexpr int I_AO = (AW / 64) * (D / 32), I_LO = (LW / 64) * (D / 32), I_WO = (D / 64) * (D / 32), I_PG = I_WO, I_PP = (PLD / 64) * (D / 32);
    constexpr int I_GU1 = (D / 64) * (2 * DE / 32), I_DN1 = (DE / 64) * (D / 32);
    constexpr int NITEMS = I_IN + I_MG + 2 * I_LR + I_AO + I_LO + I_WO + I_PG + I_PP + NE * (I_GU1 + I_DN1);
    for (int it = gw; it < NITEMS; it += NGW) {
        int r = it;
        if (r < I_IN) { const int nblk = NPROJ / 32; p0_transpose_item(F.in[3], D, NPROJ, WSP(bf16, WS_WIN), 0, scr, r / nblk, r % nblk, F.lane); continue; } r -= I_IN;
        if (r < I_MG) { const int nblk = NGATE / 32; p0_transpose_item(F.in[13], D, NGATE, WSP(bf16, WS_WIN), NPROJ, scr, r / nblk, r % nblk, F.lane); continue; } r -= I_MG;
        if (r < 2 * I_LR) { const int which = r / I_LR; r %= I_LR; const int blk = r / 8, q = r % 8;
            p0_transpose_item(F.in[which ? 8 : 6] + (size_t)blk * 128 * 128, 128, 128, WSP(bf16, which ? WS_WLRUX : WS_WLRUA) + (size_t)blk * 128 * 128, 0, scr, q / 4, q % 4, F.lane); continue; } r -= 2 * I_LR;
        if (r < I_AO) { const int nblk = D / 32; p0_transpose_item(F.in[11], AW, D, WSP(bf16, WS_WATTO), 0, scr, r / nblk, r % nblk, F.lane); continue; } r -= I_AO;
        if (r < I_LO) { const int nblk = D / 32; p0_transpose_item(F.in[12], LW, D, WSP(bf16, WS_WLRUO), 0, scr, r / nblk, r % nblk, F.lane); continue; } r -= I_LO;
        if (r < I_WO) { const int nblk = D / 32; p0_transpose_item(F.in[15], D, D, WSP(bf16, WS_WOUT), 0, scr, r / nblk, r % nblk, F.lane); continue; } r -= I_WO;
        if (r < I_PG) { const int nblk = D / 32; p0_transpose_item(F.in[24], D, D, WSP(bf16, WS_WPLG), 0, scr, r / nblk, r % nblk, F.lane); continue; } r -= I_PG;
        if (r < I_PP) { const int nblk = D / 32; p0_transpose_item(F.in[26], PLD, D, WSP(bf16, WS_WPLP), 0, scr, r / nblk, r % nblk, F.lane); continue; } r -= I_PP;
        const int e = r / (I_GU1 + I_DN1); r %= (I_GU1 + I_DN1);
        if (r < I_GU1) { const int nblk = 2 * DE / 32, kb = r / nblk, nb = r % nblk, n0 = nb * 32;
            const int j0 = n0 % DE, isup = n0 / DE; const long dest = 256 * (j0 / 128) + (j0 % 128) + 128 * isup;
            p0_transpose_item(F.in[19] + (size_t)e * D * 2 * DE, D, 2 * DE, WSP(bf16, WS_WGU) + (size_t)e * 2 * DE * D, dest - n0, scr, kb, nb, F.lane); continue; } r -= I_GU1;
        { const int nblk = D / 32; p0_transpose_item(F.in[21] + (size_t)e * DE * D, DE, D, WSP(bf16, WS_WDN) + (size_t)e * D * DE, 0, scr, r / nblk, r % nblk, F.lane); }
    }
    for (int m = gw; m < M; m += NGW) rms_row_to_bf16(F.in[0] + (size_t)m * D, F.in[2], WSP(bf16, WS_XN) + (size_t)m * D, F.lane);
    { const size_t n4 = (size_t)M * PLD / 4; const GAS f32x4* src = (const GAS f32x4*)F.in[1]; GAS unsigned long long* dst = (GAS unsigned long long*)WSP(bf16, WS_P16);
      for (size_t i = (size_t)F.bid * NTHREADS + F.tid; i < n4; i += (size_t)F.G * NTHREADS) { const f32x4 v = src[i]; dst[i] = (unsigned long long)pk2(v.x, v.y) | ((unsigned long long)pk2(v.z, v.w) << 32); } }
}

struct EpiProj { bf16* PROJ; const float* bmerge; int m0, n0;
    __device__ __forceinline__ void operator()(int r, int c, float a, float) const {
        const int n = n0 + c; float v;
        if (n < AW) v = a * 0.125f; else if (n < 3 * AW + LW) v = a; else if (n < NPROJ) v = gelu_tanh(a); else v = sigmoidf_(a + bmerge[n - NPROJ]);
        PROJ[(size_t)(m0 + r) * NIN + n] = (bf16)f2bf(v); } };
struct EpiPlain { bf16* O; int ldo, m0, n0;
    __device__ __forceinline__ void operator()(int r, int c, float a, float) const { O[(size_t)(m0 + r) * ldo + n0 + c] = (bf16)f2bf(a); } };
__device__ __forceinline__ void p1_proj(Frame& F) {
    NG_LDS(F)
    constexpr int T1 = (M / 128) * (NIN / 64), T2 = (M / 128) * (D / 64);
    for (int t = F.bid; t < T1 + T2; t += F.G) {
        if (t < T1) { const int tm = t / (NIN / 64), tn = t % (NIN / 64);
            EpiProj E{WSP(bf16, WS_PROJ), F.in[14], tm * 128, tn * 64};
            ngemm_tile<false>(As, Bs, Bs2, WSP(bf16, WS_XN), D, ARowLin{(long)tm * 128}, WSP(bf16, WS_WIN), D, tn * 64, D, F.tid, E);
        } else { const int u = t - T1, tm = u / (D / 64), tn = u % (D / 64);
            EpiPlain E{WSP(bf16, WS_PLRAW), D, tm * 128, tn * 64};
            ngemm_tile<false>(As, Bs, Bs2, WSP(bf16, WS_P16), PLD, ARowLin{(long)tm * 128}, WSP(bf16, WS_WPLP), PLD, tn * 64, PLD, F.tid, E);
        }
    }
}

__device__ __forceinline__ void p2_attn_naive(Frame& F) {
    const bf16* PROJ = WSP(bf16, WS_PROJ); bf16* ATT = WSP(bf16, WS_ATT);
    const int gw = F.bid * NWAVES + F.wave, NGW = F.G * NWAVES;
    for (int item = gw; item < BATCH * NH * SEQ; item += NGW) {
        const int t = item % SEQ, bh = item / SEQ, h = bh % NH, b = bh / NH;
        const size_t row = (size_t)b * SEQ + t;
        const float qd = bf2f(PROJ[row * NIN + h * HD + F.lane]);
        float cum = 0.f, o = 0.f;
        for (int s = t - 1; s >= 0; --s) {
            const bf16* kr = PROJ + ((size_t)b * SEQ + s) * NIN + AW + h * HD;
            const float z = wave_sum(qd * bf2f(kr[F.lane]));
            const float vd = bf2f(kr[AW + F.lane]);
            o += __expf(logsigf_(z) + cum) * vd;
            cum += logsigf_(-z);
            if (cum < -110.f) break;
        }
        ATT[row * AW + h * HD + F.lane] = (bf16)f2bf(o);
    }
}
__device__ __forceinline__ void p2_conv_naive(Frame& F) {
    const bf16* PROJ = WSP(bf16, WS_PROJ); bf16* UC = WSP(bf16, WS_HN);
    const float* cw = F.in[4]; const float* cb = F.in[5];
    for (size_t i = (size_t)F.bid * NTHREADS + F.tid; i < (size_t)M * LW; i += (size_t)F.G * NTHREADS) {
        const int c = (int)(i % LW); const size_t row = i / LW; const int t = (int)(row % SEQ);
        float a = cb[c];
#pragma unroll
        for (int j = 0; j < 4; ++j) { const int tt = t - 3 + j; if (tt >= 0) a += cw[j * LW + c] * bf2f(PROJ[(row - 3 + j) * NIN + 3 * AW + c]); }
        UC[i] = (bf16)f2bf(a);
    }
}
struct EpiLruA { float* AC; const float* ba; const float* lam; int m0, n0;
    __device__ __forceinline__ void operator()(int r, int c, float a, float) const { const int n = n0 + c;
        const float rr = sigmoidf_(a + ba[n]); AC[(size_t)(m0 + r) * LW + n] = 8.0f * rr * logsigf_(lam[n]); } };
struct EpiLruB { float* BC; const float* AC; const bf16* UC; const float* bx; int m0, n0;
    __device__ __forceinline__ void operator()(int r, int c, float a, float) const { const int n = n0 + c; const size_t o = (size_t)(m0 + r) * LW + n;
        const float ii = sigmoidf_(a + bx[n]); const float la = AC[o];
        BC[o] = sqrtf(-expm1f(2.0f * la)) * (ii * bf2f(UC[o])); } };
__device__ __forceinline__ void p3_lru_gates_naive(Frame& F) {
    NG_LDS(F)
    constexpr int T = (M / 128) * (LW / 64);
    for (int t = F.bid; t < T; t += F.G) { const int tm = t / (LW / 64), tn = t % (LW / 64), blk = (tn * 64) / 128;
        const bf16* A = WSP(bf16, WS_HN) + blk * 128;
        { EpiLruA E{WSP(float, WS_Y1), F.in[7], F.in[10], tm * 128, tn * 64};
          ngemm_tile<false>(As, Bs, Bs2, A, LW, ARowLin{(long)tm * 128}, WSP(bf16, WS_WLRUA) + (size_t)blk * 128 * 128, 128, (tn * 64) % 128, 128, F.tid, E); }
        { EpiLruB E{WSP(float, WS_YROWS), WSP(float, WS_Y1), WSP(bf16, WS_HN), F.in[9], tm * 128, tn * 64};
          ngemm_tile<false>(As, Bs, Bs2, A, LW, ARowLin{(long)tm * 128}, WSP(bf16, WS_WLRUX) + (size_t)blk * 128 * 128, 128, (tn * 64) % 128, 128, F.tid, E); }
    }
}
__device__ __forceinline__ void p3_scan_naive(Frame& F) {
    const float* AC = WSP(float, WS_Y1); const float* BC = WSP(float, WS_YROWS); const bf16* PROJ = WSP(bf16, WS_PROJ); bf16* YPRE = WSP(bf16, WS_YPRE);
    const int g = F.bid * NTHREADS + F.tid;
    if (g < BATCH * LW) { const int b = g / LW, c = g % LW; float h = 0.f;
        for (int t = 0; t < SEQ; ++t) { const size_t o = ((size_t)b * SEQ + t) * LW + c;
            h = __expf(AC[o]) * h + BC[o];
            YPRE[o] = (bf16)f2bf(bf2f(PROJ[((size_t)b * SEQ + t) * NIN + 3 * AW + LW + c]) * h); } }
}
struct EpiY1 { float* Y1; const bf16* PROJ; int m0, n0;
    __device__ __forceinline__ void operator()(int r, int c, float a, float) const { const size_t row = m0 + r; const int n = n0 + c;
        Y1[row * D + n] = bf2f(PROJ[row * NIN + NPROJ + D + n]) * a; } };
struct EpiMerged { bf16* MG; const float* Y1; const bf16* PROJ; int m0, n0;
    __device__ __forceinline__ void operator()(int r, int c, float a, float) const { const size_t row = m0 + r; const int n = n0 + c;
        MG[row * D + n] = (bf16)f2bf(Y1[row * D + n] + bf2f(PROJ[row * NIN + NPROJ + n]) * a); } };
__device__ __forceinline__ void p4_mix(Frame& F) {
    NG_LDS(F)
    constexpr int T = (M / 128) * (D / 64);
    for (int t = F.bid; t < T; t += F.G) { const int tm = t / (D / 64), tn = t % (D / 64);
        { EpiY1 E{WSP(float, WS_Y1), WSP(bf16, WS_PROJ), tm * 128, tn * 64};
          ngemm_tile<false>(As, Bs, Bs2, WSP(bf16, WS_YPRE), LW, ARowLin{(long)tm * 128}, WSP(bf16, WS_WLRUO), LW, tn * 64, LW, F.tid, E); }
        { EpiMerged E{WSP(bf16, WS_MERGED), WSP(float, WS_Y1), WSP(bf16, WS_PROJ), tm * 128, tn * 64};
          ngemm_tile<false>(As, Bs, Bs2, WSP(bf16, WS_ATT), AW, ARowLin{(long)tm * 128}, WSP(bf16, WS_WATTO), AW, tn * 64, AW, F.tid, E); }
    }
}
struct EpiH1 { float* H; const float* x; int m0, n0;
    __device__ __forceinline__ void operator()(int r, int c, float a, float) const { const size_t o = (size_t)(m0 + r) * D + n0 + c; H[o] = x[o] + a; } };
__device__ __forceinline__ void p5_out(Frame& F) {
    NG_LDS(F)
    constexpr int T = (M / 128) * (D / 64);
    for (int t = F.bid; t < T; t += F.G) { const int tm = t / (D / 64), tn = t % (D / 64);
        EpiH1 E{F.out, F.in[0], tm * 128, tn * 64};
        ngemm_tile<false>(As, Bs, Bs2, WSP(bf16, WS_MERGED), D, ARowLin{(long)tm * 128}, WSP(bf16, WS_WOUT), D, tn * 64, D, F.tid, E); }
}
__device__ __forceinline__ void p6_router(Frame& F) {
    const int gw = F.bid * NWAVES + F.wave, NGW = F.G * NWAVES;
    const float* g = F.in[16]; const float* Wr = F.in[17]; const float* br = F.in[18];
    int* tokE = (int*)(F.ws + WS_SMALL + SM_TOKE); int* tokS = (int*)(F.ws + WS_SMALL + SM_TOKSLOT); float* tokG = (float*)(F.ws + WS_SMALL + SM_TOKGATE);
    int* list = (int*)(F.ws + WS_SMALL + SM_LIST);
    for (int m = gw; m < M; m += NGW) {
        const GAS f32x4* xr = (const GAS f32x4*)(F.out + (size_t)m * D) + F.lane; const GAS f32x4* gr = (const GAS f32x4*)g + F.lane;
        f32x4 v[4]; float s2 = 0.f;
#pragma unroll
        for (int j = 0; j < 4; ++j) { v[j] = xr[64 * j]; s2 += (v[j].x * v[j].x + v[j].y * v[j].y) + (v[j].z * v[j].z + v[j].w * v[j].w); }
        const float rstd = 1.f / sqrtf(wave_sum(s2) * (1.f / D) + EPS);
#pragma unroll
        for (int j = 0; j < 4; ++j) { const f32x4 gg = gr[64 * j]; v[j].x *= rstd * gg.x; v[j].y *= rstd * gg.y; v[j].z *= rstd * gg.z; v[j].w *= rstd * gg.w; }
        GAS unsigned long long* o8 = (GAS unsigned long long*)(WSP(bf16, WS_XN) + (size_t)m * D) + F.lane;
#pragma unroll
        for (int j = 0; j < 4; ++j) o8[64 * j] = (unsigned long long)pk2(v[j].x, v[j].y) | ((unsigned long long)pk2(v[j].z, v[j].w) << 32);
        float lg[NE];
#pragma unroll
        for (int e = 0; e < NE; ++e) lg[e] = 0.f;
#pragma unroll
        for (int j = 0; j < 4; ++j)
#pragma unroll
            for (int c = 0; c < 4; ++c) { const int i = 4 * (F.lane + 64 * j) + c; const float xv = v[j][c]; const GAS f32x4* wr = (const GAS f32x4*)(Wr + (size_t)i * NE);
#pragma unroll
                for (int q = 0; q < 8; ++q) { const f32x4 w = wr[q]; lg[4 * q] += xv * w.x; lg[4 * q + 1] += xv * w.y; lg[4 * q + 2] += xv * w.z; lg[4 * q + 3] += xv * w.w; } }
#pragma unroll
        for (int e = 0; e < NE; ++e) lg[e] = wave_sum(lg[e]) + br[e];
        float tv[TOPK]; int te[TOPK];
#pragma unroll
        for (int k = 0; k < TOPK; ++k) { float best = -INFINITY; int bi = 0;
#pragma unroll
            for (int e = 0; e < NE; ++e) if (lg[e] > best) { best = lg[e]; bi = e; }
            tv[k] = best; te[k] = bi;
#pragma unroll
            for (int e = 0; e < NE; ++e) if (e == bi) lg[e] = -INFINITY; }
        float den = 0.f, ex[TOPK];
#pragma unroll
        for (int k = 0; k < TOPK; ++k) { ex[k] = __expf(tv[k] - tv[0]); den += ex[k]; }
        if (F.lane < TOPK) {
            int e = te[0]; float gt = ex[0];
#pragma unroll
            for (int k = 1; k < TOPK; ++k) if (F.lane == k) { e = te[k]; gt = ex[k]; }
            const int slot = (int)atomicAdd((unsigned*)(F.ctl + CW_COUNTS + e), 1u);
            tokE[m * TOPK + F.lane] = e; tokS[m * TOPK + F.lane] = slot; tokG[m * TOPK + F.lane] = gt / den;
            list[e * M + slot] = m;
        }
    }
}
__device__ __forceinline__ void moe_segments(Frame& F, LAS int* seg) {
    __syncthreads();
    if (F.tid == 0) { int acc = 0; for (int e = 0; e < NE; ++e) { const int c = (int)__hip_atomic_load(F.ctl + CW_COUNTS + e, RLX_AGENT); seg[e] = acc; seg[64 + e] = c; acc += (c + 255) & ~255; } seg[NE] = acc; }
    __syncthreads();
}
struct ARowGather { const int* list; int cnt; int l0; __device__ __forceinline__ long operator()(int r) const { const int l = l0 + r; return l < cnt ? (long)list[l] : -1L; } };
struct EpiSwiglu { bf16* H; const float* bgu; long row0; int j0;
    __device__ __forceinline__ void operator()(int r, int c, float ag, float au) const { const int j = j0 + c;
        float gate = ag + bgu[j], up = au + bgu[DE + j];
        gate = fminf(gate, 7.0f); up = fminf(fmaxf(up, -7.0f), 7.0f);
        const float glu = gate * sigmoidf_(gate * 1.702f);
        H[(size_t)(row0 + r) * DE + j] = (bf16)f2bf((up + 1.0f) * glu); } };
__device__ __forceinline__ void p7_moe_up(Frame& F) {
    NG_LDS(F)
    LAS int* seg = (LAS int*)(F.lds + 65536);
    moe_segments(F, seg);
    const int total = seg[NE]; const int nmt = total / 128, T = nmt * (DE / 64);
    const int* list = (const int*)(F.ws + WS_SMALL + SM_LIST);
    for (int t = F.bid; t < T; t += F.G) { const int tm = t / (DE / 64), tn = t % (DE / 64); const int row0 = tm * 128;
        int e = 0;
#pragma unroll 1
        for (int q = 1; q < NE; ++q) if (seg[q] <= row0) e = q;
        const int cnt = seg[64 + e], l0 = row0 - seg[e];
        if (l0 >= cnt) continue;
        const int j0 = tn * 64; const int brow0 = 256 * (j0 / 128) + (j0 % 128);
        EpiSwiglu E{WSP(bf16, WS_HMOE), F.in[20] + (size_t)e * 2 * DE, (long)row0, j0};
        ngemm_tile<true>(As, Bs, Bs2, WSP(bf16, WS_XN), D, ARowGather{list + (size_t)e * M, cnt, l0}, WSP(bf16, WS_WGU) + (size_t)e * 2 * DE * D, D, brow0, D, F.tid, E); }
}
struct EpiDown { bf16* Y; const float* bd; long row0; int n0;
    __device__ __forceinline__ void operator()(int r, int c, float a, float) const { Y[(size_t)(row0 + r) * D + n0 + c] = (bf16)f2bf(a + bd[n0 + c]); } };
__device__ __forceinline__ void p8_moe_down(Frame& F) {
    NG_LDS(F)
    LAS int* seg = (LAS int*)(F.lds + 65536);
    moe_segments(F, seg);
    const int total = seg[NE]; const int nmt = total / 128, T = nmt * (D / 64);
    for (int t = F.bid; t < T; t += F.G) { const int tm = t / (D / 64), tn = t % (D / 64); const int row0 = tm * 128;
        int e = 0;
#pragma unroll 1
        for (int q = 1; q < NE; ++q) if (seg[q] <= row0) e = q;
        const int cnt = seg[64 + e], l0 = row0 - seg[e];
        if (l0 >= cnt) continue;
        EpiDown E{WSP(bf16, WS_YROWS), F.in[22] + (size_t)e * D, (long)row0, tn * 64};
        ngemm_tile<false>(As, Bs, Bs2, WSP(bf16, WS_HMOE), DE, ARowLin{(long)row0}, WSP(bf16, WS_WDN) + (size_t)e * D * DE, DE, tn * 64, DE, F.tid, E); }
}
__device__ __forceinline__ void p9_combine(Frame& F) {
    LAS int* seg = (LAS int*)(F.lds + 65536);
    moe_segments(F, seg);
    const int gw = F.bid * NWAVES + F.wave, NGW = F.G * NWAVES;
    const int* tokE = (const int*)(F.ws + WS_SMALL + SM_TOKE); const int* tokS = (const int*)(F.ws + WS_SMALL + SM_TOKSLOT); const float* tokG = (const float*)(F.ws + WS_SMALL + SM_TOKGATE);
    float* plstat = (float*)(F.ws + WS_SMALL + SM_PLSTAT);
    for (int m = gw; m < M; m += NGW) {
        GAS f32x4* hr = (GAS f32x4*)(F.out + (size_t)m * D) + F.lane;
        f32x4 v[4];
#pragma unroll
        for (int j = 0; j < 4; ++j) v[j] = hr[64 * j];
#pragma unroll
        for (int k = 0; k < TOPK; ++k) { const int e = tokE[m * TOPK + k]; const long row = seg[e] + tokS[m * TOPK + k]; const float gt = tokG[m * TOPK + k];
            const GAS unsigned long long* yr = (const GAS unsigned long long*)(WSP(bf16, WS_YROWS) + (size_t)row * D) + F.lane;
#pragma unroll
            for (int j = 0; j < 4; ++j) { const unsigned long long w = yr[64 * j]; const unsigned lo = (unsigned)w, hi = (unsigned)(w >> 32);
                v[j].x += gt * __uint_as_float(lo << 16); v[j].y += gt * __uint_as_float(lo & 0xffff0000u); v[j].z += gt * __uint_as_float(hi << 16); v[j].w += gt * __uint_as_float(hi & 0xffff0000u); } }
        float s2 = 0.f;
#pragma unroll
        for (int j = 0; j < 4; ++j) { hr[64 * j] = v[j]; s2 += (v[j].x * v[j].x + v[j].y * v[j].y) + (v[j].z * v[j].z + v[j].w * v[j].w); }
        const float rstd = 1.f / sqrtf(wave_sum(s2) * (1.f / D) + EPS);
        const GAS f32x4* gr = (const GAS f32x4*)F.in[23] + F.lane;
        GAS unsigned long long* o8 = (GAS unsigned long long*)(WSP(bf16, WS_HN) + (size_t)m * D) + F.lane;
#pragma unroll
        for (int j = 0; j < 4; ++j) { const f32x4 gg = gr[64 * j];
            o8[64 * j] = (unsigned long long)pk2(v[j].x * rstd * gg.x, v[j].y * rstd * gg.y) | ((unsigned long long)pk2(v[j].z * rstd * gg.z, v[j].w * rstd * gg.w) << 32); }
        const GAS unsigned long long* pr = (const GAS unsigned long long*)(WSP(bf16, WS_PLRAW) + (size_t)m * D) + F.lane; float p2 = 0.f;
#pragma unroll
        for (int j = 0; j < 4; ++j) { const unsigned long long w = pr[64 * j]; const unsigned lo = (unsigned)w, hi = (unsigned)(w >> 32);
            const float a = __uint_as_float(lo << 16), b = __uint_as_float(lo & 0xffff0000u), c = __uint_as_float(hi << 16), d = __uint_as_float(hi & 0xffff0000u); p2 += (a * a + b * b) + (c * c + d * d); }
        const float prs = 1.f / sqrtf(wave_sum(p2) * (1.f / D) + EPS);
        if (F.lane == 0) plstat[m] = prs;
    }
}
struct EpiPl { float* H; const bf16* PLRAW; const float* plstat; const float* bg; const float* gpost; int m0, n0;
    __device__ __forceinline__ void operator()(int r, int c, float a, float) const { const size_t row = m0 + r; const int n = n0 + c; const size_t o = row * D + n;
        const float gate = sigmoidf_(a + bg[n]); const float pl = bf2f(PLRAW[o]) * plstat[row] * gpost[n]; H[o] = H[o] + gate * pl; } };
__device__ __forceinline__ void p10_pl(Frame& F) {
    NG_LDS(F)
    constexpr int T = (M / 128) * (D / 64);
    for (int t = F.bid; t < T; t += F.G) { const int tm = t / (D / 64), tn = t % (D / 64);
        EpiPl E{F.out, WSP(bf16, WS_PLRAW), (const float*)(F.ws + WS_SMALL + SM_PLSTAT), F.in[25], F.in[27], tm * 128, tn * 64};
        ngemm_tile<false>(As, Bs, Bs2, WSP(bf16, WS_HN), D, ARowLin{(long)tm * 128}, WSP(bf16, WS_WPLG), D, tn * 64, D, F.tid, E); }
}
__device__ __forceinline__ void p11_final(Frame& F) {
    const int gw = F.bid * NWAVES + F.wave, NGW = F.G * NWAVES;
    for (int m = gw; m < M; m += NGW) {
        GAS f32x4* hr = (GAS f32x4*)(F.out + (size_t)m * D) + F.lane; const GAS f32x4* gr = (const GAS f32x4*)F.in[28] + F.lane;
        f32x4 v[4]; float s2 = 0.f;
#pragma unroll
        for (int j = 0; j < 4; ++j) { v[j] = hr[64 * j]; s2 += (v[j].x * v[j].x + v[j].y * v[j].y) + (v[j].z * v[j].z + v[j].w * v[j].w); }
        const float rstd = 1.f / sqrtf(wave_sum(s2) * (1.f / D) + EPS);
#pragma unroll
        for (int j = 0; j < 4; ++j) { const f32x4 gg = gr[64 * j]; hr[64 * j] = (f32x4){v[j].x * rstd * gg.x, v[j].y * rstd * gg.y, v[j].z * rstd * gg.z, v[j].w * rstd * gg.w}; }
    }
}

struct Args { const float* in[29]; float* out; unsigned char* ws; int ph_lo, ph_hi; };
__global__ void __launch_bounds__(NTHREADS, 2) hyb_fwd(Args args) {
    extern __shared__ __attribute__((aligned(16))) unsigned char lds[];
    Frame F;
    F.lds = (LAS unsigned char*)lds; F.MISC = (volatile LAS unsigned*)(F.lds + MISC_OFF);
    F.tid = threadIdx.x; F.lane = F.tid & 63; F.wave = __builtin_amdgcn_readfirstlane(F.tid >> 6);
    F.G = gridDim.x; F.bid = blockIdx.x;
    F.ws = args.ws; F.ctl = (gu32*)(args.ws + WS_CTL); F.out = args.out;
#pragma unroll
    for (int i = 0; i < 29; ++i) F.in[i] = args.in[i];
    for (int u = F.tid; u < (LDS_BYTES - LDSCTL_OFF) / 4; u += NTHREADS) ((LAS unsigned*)(F.lds + LDSCTL_OFF))[u] = 0u;
    __syncthreads();
    const int lo = args.ph_lo, hi = args.ph_hi;
    const bool multi = (hi - lo) > 1;
    XcdBarrier bar; bar.bar = (unsigned*)(F.ctl + CW_BAR); bar.x = 0; bar.st = nullptr;
    if (multi) bar = xcd_barrier_post((unsigned*)(F.ctl + CW_BAR), F.MISC + 8);
#define IN(k) (lo <= (k) && (k) < hi)
#define SEAM(k) do { if (IN(k) && IN((k) + 1)) xcd_barrier(bar); } while (0)
    if (IN(0)) { p0_prologue(F); } SEAM(0);
    if (IN(1)) { p1_proj(F); } SEAM(1);
    if (IN(2)) { p2_attn_naive(F); p2_conv_naive(F); } SEAM(2);
    if (IN(3)) { p3_lru_gates_naive(F); } SEAM(3);
    if (IN(4)) { p3_scan_naive(F); } SEAM(4);
    if (IN(5)) { p4_mix(F); } SEAM(5);
    if (IN(6)) { p5_out(F); } SEAM(6);
    if (IN(7)) { p6_router(F); } SEAM(7);
    if (IN(8)) { p7_moe_up(F); } SEAM(8);
    if (IN(9)) { p8_moe_down(F); } SEAM(9);
    if (IN(10)) { p9_combine(F); } SEAM(10);
    if (IN(11)) { p10_pl(F); } SEAM(11);
    if (IN(12)) { p11_final(F); }
#undef IN
#undef SEAM
}
extern "C" void kernel_launch(void* const* d_in, const int* in_sizes, int n_in, void* d_out, int out_size, void* d_ws, size_t ws_size, hipStream_t stream) {
    static int grid = 0;
    if (grid == 0) {
        if (n_in != 29 || in_sizes[0] != M * D || out_size != M * D || ws_size < WS_END) { fprintf(stderr, "kernel_launch: unexpected shapes/workspace (n_in %d, ws %zu)\n", n_in, ws_size); grid = -1; return; }
        int dev = 0, cus = 0, per_cu = 0;
        if (hipGetDevice(&dev) != hipSuccess || hipDeviceGetAttribute(&cus, hipDeviceAttributeMultiprocessorCount, dev) != hipSuccess) { grid = -1; return; }
        if (hipFuncSetAttribute((const void*)hyb_fwd, hipFuncAttributeMaxDynamicSharedMemorySize, LDS_BYTES) != hipSuccess) { grid = -1; return; }
        if (hipOccupancyMaxActiveBlocksPerMultiprocessor(&per_cu, (const void*)hyb_fwd, NTHREADS, LDS_BYTES) != hipSuccess || per_cu < 1) { fprintf(stderr, "kernel_launch: occupancy query says %d\n", per_cu); }
        (void)hipGetLastError();
        grid = cus;
    }
    if (grid < 0) return;
    (void)hipMemsetAsync((char*)d_ws + WS_CTL, 0, CTL_ZERO_BYTES, stream);
    Args a{};
    for (int i = 0; i < 29; ++i) a.in[i] = (const float*)d_in[i];
    a.out = (float*)d_out; a.ws = (unsigned char*)d_ws;
    for (int ph = 0; ph < NPHASE; ++ph) {
        a.ph_lo = ph; a.ph_hi = ph + 1;
        hipLaunchKernelGGL(hyb_fwd, dim3(grid), dim3(NTHREADS), LDS_BYTES, stream, a);
    }
}
```

```cpp
#include <hip/hip_runtime.h>
#include <cstdio>
#include <cstdint>

#ifndef MK_N_LAUNCHES
#define MK_N_LAUNCHES 1
#endif

#define GAS __attribute__((address_space(1)))
#define LAS __attribute__((address_space(3)))
typedef unsigned short bf16;
typedef unsigned v4u __attribute__((ext_vector_type(4)));
typedef float f32x4 __attribute__((ext_vector_type(4)));
typedef GAS unsigned gu32;
#define RLX_AGENT __ATOMIC_RELAXED, __HIP_MEMORY_SCOPE_AGENT
#define LDS_WAIT() asm volatile("s_waitcnt lgkmcnt(0)" ::: "memory")
#define VM_WAIT() asm volatile("s_waitcnt vmcnt(0)" ::: "memory")

constexpr int BATCH = 2, SEQ = 8192, D = 1024, M = BATCH * SEQ;
constexpr int NH = 8, HD = 64, AW = 512, LW = 1024, NPROJ = 3584, NGATE = 2048, NIN = NPROJ + NGATE;
constexpr int PLD = 256, NE = 32, TOPK = 4, DE = 1024;
constexpr int MOE_ROWS = M * TOPK + NE * 256;
constexpr float EPS = 1e-6f;
constexpr int NWAVES = 8, NTHREADS = 512;
constexpr int NPHASE = 13;

constexpr size_t MiB = 1u << 20;
constexpr size_t WS_CTL = 0, CTL_ZERO_BYTES = 1 * MiB;
constexpr size_t WS_WLRUA = 2 * MiB, WS_WLRUX = WS_WLRUA + 256 * 1024;
constexpr size_t WS_WATTO = 3 * MiB, WS_WLRUO = 4 * MiB, WS_WOUT = 6 * MiB, WS_WPLG = 8 * MiB, WS_WPLP = 10 * MiB;
constexpr size_t WS_WIN = 12 * MiB;
constexpr size_t WS_P16 = 24 * MiB;
constexpr size_t WS_WGU = 32 * MiB;
constexpr size_t WS_WDN = 160 * MiB;
constexpr size_t WS_XN = 224 * MiB;
constexpr size_t WS_PROJ = 256 * MiB;
constexpr size_t WS_PLRAW = 432 * MiB;
constexpr size_t WS_ATT = 464 * MiB;
constexpr size_t WS_HLOC = 480 * MiB, WS_PCUM = 512 * MiB, WS_YPRE = 544 * MiB;
constexpr size_t WS_Y1 = 576 * MiB;
constexpr size_t WS_MERGED = 640 * MiB;
constexpr size_t WS_HN = 672 * MiB;
constexpr size_t WS_YROWS = 704 * MiB;
constexpr size_t WS_SMALL = 848 * MiB;
constexpr size_t WS_HMOE = 856 * MiB;
constexpr size_t WS_END = 1000 * MiB;
constexpr size_t SM_TOKE = 0, SM_TOKSLOT = 256 * 1024, SM_TOKGATE = 512 * 1024, SM_LIST = 1 * MiB  , SM_PLSTAT = 3 * MiB  ;
constexpr int CW_TMO = 0, CW_CODE = 1, CW_COUNTS = 64  , CW_BAR = 4096;

__device__ __forceinline__ float bf2f(bf16 v) { return __uint_as_float(((unsigned)v) << 16); }
__device__ __forceinline__ unsigned f2bf(float f) { unsigned u = __builtin_bit_cast(unsigned, f); return (u + 0x7fffu + ((u >> 16) & 1u)) >> 16; }
__device__ __forceinline__ unsigned pk2(float lo, float hi) { return f2bf(lo) | (f2bf(hi) << 16); }
__device__ __forceinline__ float sigmoidf_(float x) { return 1.0f / (1.0f + __expf(-x)); }
__device__ __forceinline__ float logsigf_(float x) { return fminf(x, 0.f) - log1pf(__expf(-fabsf(x))); }
__device__ __forceinline__ float gelu_tanh(float x) { const float u = 0.7978845608028654f * (x + 0.044715f * x * x * x); return 0.5f * x * (1.0f + tanhf(u)); }
__device__ __forceinline__ float wave_sum(float v) {
#pragma unroll
    for (int o = 1; o < 64; o <<= 1) v += __shfl_xor(v, o);
    return v;
}

#define XB_TMO      128
#define XB_XCNT(j)  (256  + 64 * (j))
#define XB_XSUB(j)  (1280 + 64 * (j))
#define XB_XGEN(j)  (2304 + 64 * (j))
#define XB_TOP      3328
#define XB_TOPGEN   3392
#define XCD_BAR_WORDS 3456
#define XB_SPIN_CAP (1u << 18)
__device__ __forceinline__ unsigned xb_ld(unsigned* p)              { return __hip_atomic_load(p, __ATOMIC_RELAXED, __HIP_MEMORY_SCOPE_AGENT); }
__device__ __forceinline__ unsigned xb_add(unsigned* p, unsigned v) { return __hip_atomic_fetch_add(p, v, __ATOMIC_RELAXED, __HIP_MEMORY_SCOPE_AGENT); }
__device__ __forceinline__ unsigned xb_xcc_id() { return (unsigned)__builtin_amdgcn_s_getreg((3 << 11) | 20) & 0xFu; }
#define XB_SPIN(cond, bar) do { unsigned _sp = 0; while (cond) { __builtin_amdgcn_s_sleep(1); \
    if ((++_sp & 255u) == 0u) { if (xb_ld(&(bar)[XB_TMO])) break; if (_sp > XB_SPIN_CAP) { atomicAdd(&(bar)[XB_TMO], 1u); break; } } } } while (0)
struct XcdBarrier { unsigned* bar; unsigned x; volatile LAS unsigned* st; };
__device__ __forceinline__ XcdBarrier xcd_barrier_post(unsigned* bar, volatile LAS unsigned* st) {
    XcdBarrier b; b.bar = bar; b.x = xb_xcc_id(); b.st = st;
    if (threadIdx.x == 0) (void)xb_add(&bar[XB_XCNT(b.x)], 1u);
    return b;
}
__device__ __forceinline__ void xcd_barrier_complete(unsigned* bar, unsigned x, unsigned& nloc, unsigned& nx) {
    const unsigned G = gridDim.x * gridDim.y * gridDim.z;
    unsigned sum, cnt, mine, sp = 0u;
    for (;;) {
        sum = 0u; cnt = 0u; mine = 0u;
#pragma unroll
        for (unsigned j = 0; j < 16; ++j) { const unsigned c = xb_ld(&bar[XB_XCNT(j)]); sum += c; cnt += (c > 0u) ? 1u : 0u; mine = (j == x) ? c : mine; }
        if (sum == G) break;
        __builtin_amdgcn_s_sleep(1);
        if ((++sp & 255u) == 0u) { if (xb_ld(&bar[XB_TMO])) break; if (sp > XB_SPIN_CAP) { atomicAdd(&bar[XB_TMO], 1u); break; } }
    }
    nloc = mine > 0u ? mine : 1u; nx = cnt > 0u ? cnt : 1u;
}
__device__ __forceinline__ void xcd_barrier(const XcdBarrier& b) {
    asm volatile("s_waitcnt vmcnt(0)" ::: "memory");
    __syncthreads();
    if (threadIdx.x == 0) {
        unsigned* bar = b.bar;
        __builtin_amdgcn_s_waitcnt(0);
        unsigned nloc = b.st[0], nx = b.st[1];
        if (nloc == 0u) { xcd_barrier_complete(bar, b.x, nloc, nx); b.st[0] = nloc; b.st[1] = nx; }
        const unsigned old = xb_add(&bar[XB_XSUB(b.x)], 1u);
        const unsigned gen = old / nloc;
        if (old + 1u == (gen + 1u) * nloc) {
            __builtin_amdgcn_fence(__ATOMIC_RELEASE, "agent");
            asm volatile("s_waitcnt vmcnt(0)" ::: "memory");
            const unsigned og = xb_add(&bar[XB_TOP], 1u);
            const unsigned tg = og / nx;
            if (og + 1u == (tg + 1u) * nx) xb_add(&bar[XB_TOPGEN], 1u);
            else XB_SPIN(xb_ld(&bar[XB_TOPGEN]) == tg, bar);
            __builtin_amdgcn_fence(__ATOMIC_ACQUIRE, "agent");
            xb_add(&bar[XB_XGEN(b.x)], 1u);
            asm volatile("s_waitcnt vmcnt(0)" ::: "memory");
        } else {
            XB_SPIN(xb_ld(&bar[XB_XGEN(b.x)]) == gen, bar);
            __builtin_amdgcn_fence(__ATOMIC_ACQUIRE, "agent");
            asm volatile("s_waitcnt vmcnt(0)" ::: "memory");
        }
    }
    __syncthreads();
}

constexpr int RING_BYTES = 131072, LDSCTL_OFF = RING_BYTES, MISC_OFF = LDSCTL_OFF + 320, LDS_BYTES = 147456;
struct Args { const float* in[29]; float* out; unsigned char* ws; int ph_lo, ph_hi; };
struct Frame {
    LAS unsigned char* lds; volatile LAS unsigned* MISC; gu32* ctl;
    int tid, lane, wave, G, bid;
    float* out; unsigned char* ws;
};
#define WSP(T, off) ((T*)(F.ws + (off)))


namespace pg8 {
typedef unsigned short bf16_t;
typedef short bf16x8 __attribute__((ext_vector_type(8)));
typedef unsigned u32x4 __attribute__((ext_vector_type(4)));
typedef unsigned u32x2 __attribute__((ext_vector_type(2)));
typedef float f32x2 __attribute__((ext_vector_type(2)));
constexpr int BM = 256, BK = 64, HALF = 128, HTB = HALF * BK * 2, STAGE_BYTES = 8 * HTB, NXCD = 8, WGM = 8;
__host__ __device__ __forceinline__ int lds_byte(int r, int c) { const int st = (r >> 4) * 2 + (c >> 5), rr = r & 15, cc = c & 31, ob = rr * 64 + cc * 2; return st * 1024 + (ob ^ (((ob >> 9) & 1) << 5)); }
__host__ __device__ __forceinline__ void stage_rc(int b, int& R, int& C) { const int st = b / 1024, sb = b % 1024, swz = sb ^ (((sb >> 9) & 1) << 5); R = (st >> 1) * 16 + swz / 64; C = (st & 1) * 32 + (swz % 64) / 2; }
__host__ __device__ __forceinline__ int perm32(int rho) { const int n = rho >> 4, i = rho & 15; return 8 * (i >> 2) + 4 * n + (i & 3); }
struct Unit { int pm, pn, e; };
struct Gemm { const bf16_t* A; const bf16_t* Bt; int K; size_t bt_estride; };
__device__ __forceinline__ void swz_tile(int L, int nM, int nN, int& pm, int& pn) {
    const int nwg = nM * nN; int wgid = L; { const int q = nwg / NXCD, r = nwg % NXCD, xcd = wgid % NXCD, off = wgid / NXCD; wgid = (xcd < r ? xcd * (q + 1) : r * (q + 1) + (xcd - r) * q) + off; }
    const int nig = WGM * nN, gid = wgid / nig, fm = gid * WGM, gsz = (nM - fm) < WGM ? (nM - fm) : WGM;
    pm = fm + ((wgid % nig) % gsz); pn = (wgid % nig) / gsz;
}
struct StaticOrder { int nM, nN, nwg, G, c;
    __device__ void init(int M_, int N_, int G_, int c_) { nM = M_ / BM; nN = N_ / BM; nwg = nM * nN; G = G_; c = c_; }
    __device__ bool next(int i, Unit& u) const { const long L = (long)i * G + c; if (L >= nwg) return false; swz_tile((int)L, nM, nN, u.pm, u.pn); u.e = 0; return true; }
    __device__ __forceinline__ void gather_rows(const Unit&, int, int&, int&) const {}
};
struct MoeOrder { const LAS int* seg; const int* list; int nM, nN, nwg, G, c;
    __device__ void init(const LAS int* seg_, const int* list_, int N_, int G_, int c_) { seg = seg_; list = list_; nM = seg_[32] / BM; nN = N_ / BM; nwg = nM * nN; G = G_; c = c_; }
    __device__ bool next(int i, Unit& u) const { const long L = (long)i * G + c; if (L >= nwg) return false; swz_tile((int)L, nM, nN, u.pm, u.pn);
        int e = 0; const int r0 = u.pm * BM;
#pragma unroll 1
        for (int q = 1; q < 32; ++q) if (seg[q] <= r0) e = q;
        u.e = e; return true; }
    __device__ __forceinline__ void gather_rows(const Unit& u, int r, int& t0, int& dummy) const {
        const int l = u.pm * BM - seg[u.e] + r; const int cnt = seg[64 + u.e]; t0 = list[(size_t)u.e * 16384 + (l < cnt ? l : 0)]; dummy = 0; }
};
__device__ __forceinline__ unsigned cvt_pk_bf16(float lo, float hi) { unsigned r; asm volatile("v_cvt_pk_bf16_f32 %0, %1, %2" : "=v"(r) : "v"(lo), "v"(hi)); return r; }
__device__ __forceinline__ float fsig(float x) { return __builtin_amdgcn_rcpf(1.0f + __builtin_amdgcn_exp2f(-1.4426950408889634f * x)); }
__device__ __forceinline__ float fgelu(float x) { return x * fsig(1.5957691216057308f * (x + 0.044715f * x * x * x)); }
__device__ __forceinline__ float bflo(unsigned w) { return __uint_as_float(w << 16); }
__device__ __forceinline__ float bfhi(unsigned w) { return __uint_as_float(w & 0xffff0000u); }

struct EpiProj { static constexpr bool PERM = true; bf16_t* O; const float* bmerge;
    __device__ __forceinline__ void operator()(const f32x4 (&acc)[2][2][4][2], const Unit& u, int wr, int wc, int fr, int fq) const {
        const int mode = u.pn < 2 ? 0 : (u.pn < 10 ? 1 : (u.pn < 14 ? 2 : 3));
        const int row0 = u.pm * BM + wr * 64 + fr, col0 = u.pn * BM + wc * 32 + 8 * fq;
        f32x4 bv[2][2];
#pragma unroll
        for (int bj = 0; bj < 2; ++bj)
#pragma unroll
            for (int n = 0; n < 2; ++n) bv[bj][n] = (mode == 3) ? *(const f32x4*)(bmerge + (col0 - 3584) + bj * HALF + 4 * n) : (f32x4){0.f, 0.f, 0.f, 0.f};
#pragma unroll
        for (int ai = 0; ai < 2; ++ai)
#pragma unroll
            for (int m = 0; m < 4; ++m) { bf16_t* rowp = O + (size_t)(row0 + ai * HALF + m * 16) * 5632 + col0;
#pragma unroll
                for (int bj = 0; bj < 2; ++bj) { f32x4 v0 = acc[ai][bj][m][0] + bv[bj][0], v1 = acc[ai][bj][m][1] + bv[bj][1];
                    if (mode == 0) { v0 = v0 * 0.18033688011112042f; v1 = v1 * 0.18033688011112042f; }
                    else if (mode == 2) {
#pragma unroll
                        for (int i = 0; i < 4; ++i) { v0[i] = fgelu(v0[i]); v1[i] = fgelu(v1[i]); } }
                    else if (mode == 3) {
#pragma unroll
                        for (int i = 0; i < 4; ++i) { v0[i] = fsig(v0[i]); v1[i] = fsig(v1[i]); } }
                    u32x4 w; w.x = cvt_pk_bf16(v0[0], v0[1]); w.y = cvt_pk_bf16(v0[2], v0[3]); w.z = cvt_pk_bf16(v1[0], v1[1]); w.w = cvt_pk_bf16(v1[2], v1[3]);
                    *(u32x4*)(rowp + bj * HALF) = w; } }
    }
};
struct EpiBf16 { static constexpr bool PERM = true; bf16_t* O; int ldc; const float* bias; int bias_estride;
    __device__ __forceinline__ void operator()(const f32x4 (&acc)[2][2][4][2], const Unit& u, int wr, int wc, int fr, int fq) const {
        const int row0 = u.pm * BM + wr * 64 + fr, col0 = u.pn * BM + wc * 32 + 8 * fq;
        f32x4 bv[2][2];
#pragma unroll
        for (int bj = 0; bj < 2; ++bj)
#pragma unroll
            for (int n = 0; n < 2; ++n) bv[bj][n] = bias ? *(const f32x4*)(bias + (size_t)u.e * bias_estride + col0 + bj * HALF + 4 * n) : (f32x4){0.f, 0.f, 0.f, 0.f};
#pragma unroll
        for (int ai = 0; ai < 2; ++ai)
#pragma unroll
            for (int m = 0; m < 4; ++m) { bf16_t* rowp = O + (size_t)(row0 + ai * HALF + m * 16) * ldc + col0;
#pragma unroll
                for (int bj = 0; bj < 2; ++bj) { const f32x4 v0 = acc[ai][bj][m][0] + bv[bj][0], v1 = acc[ai][bj][m][1] + bv[bj][1];
                    u32x4 w; w.x = cvt_pk_bf16(v0[0], v0[1]); w.y = cvt_pk_bf16(v0[2], v0[3]); w.z = cvt_pk_bf16(v1[0], v1[1]); w.w = cvt_pk_bf16(v1[2], v1[3]);
                    *(u32x4*)(rowp + bj * HALF) = w; } }
    }
};
struct EpiSwiglu { static constexpr bool PERM = true; bf16_t* H; const float* bgu;
    __device__ __forceinline__ void operator()(const f32x4 (&acc)[2][2][4][2], const Unit& u, int wr, int wc, int fr, int fq) const {
        const int row0 = u.pm * BM + wr * 64 + fr, j0 = u.pn * HALF + wc * 32 + 8 * fq;
        const float* bb = bgu + (size_t)u.e * 2048 + j0;
        f32x4 bg[2], bu[2];
#pragma unroll
        for (int n = 0; n < 2; ++n) { bg[n] = *(const f32x4*)(bb + 4 * n); bu[n] = *(const f32x4*)(bb + 1024 + 4 * n); }
#pragma unroll
        for (int ai = 0; ai < 2; ++ai)
#pragma unroll
            for (int m = 0; m < 4; ++m) { float o[8];
#pragma unroll
                for (int n = 0; n < 2; ++n)
#pragma unroll
                    for (int i = 0; i < 4; ++i) { float gate = acc[ai][0][m][n][i] + bg[n][i], up = acc[ai][1][m][n][i] + bu[n][i];
                        gate = fminf(gate, 7.0f); up = fminf(fmaxf(up, -7.0f), 7.0f);
                        o[4 * n + i] = (up + 1.0f) * gate * fsig(1.702f * gate); }
                u32x4 w; w.x = cvt_pk_bf16(o[0], o[1]); w.y = cvt_pk_bf16(o[2], o[3]); w.z = cvt_pk_bf16(o[4], o[5]); w.w = cvt_pk_bf16(o[6], o[7]);
                *(u32x4*)(H + (size_t)(row0 + ai * HALF + m * 16) * 1024 + j0) = w; }
    }
};
struct EpiY1 { static constexpr bool PERM = false; float* Y1; const bf16_t* PROJ;
    __device__ __forceinline__ void operator()(const f32x4 (&acc)[2][2][4][2], const Unit& u, int wr, int wc, int fr, int fq) const {
        const int row0 = u.pm * BM + wr * 64 + fr, col0 = u.pn * BM + wc * 32 + 4 * fq;
#pragma unroll
        for (int ai = 0; ai < 2; ++ai)
#pragma unroll
            for (int m = 0; m < 4; ++m) { const size_t row = row0 + ai * HALF + m * 16;
#pragma unroll
                for (int bj = 0; bj < 2; ++bj)
#pragma unroll
                    for (int n = 0; n < 2; ++n) { const int c = col0 + bj * HALF + n * 16; const u32x2 g = *(const u32x2*)(PROJ + row * 5632 + 3584 + 1024 + c); const f32x4 a = acc[ai][bj][m][n];
                        *(f32x4*)(Y1 + row * 1024 + c) = (f32x4){a[0] * bflo(g.x), a[1] * bfhi(g.x), a[2] * bflo(g.y), a[3] * bfhi(g.y)}; } }
    }
};
struct EpiMerged { static constexpr bool PERM = false; bf16_t* MG; const float* Y1; const bf16_t* PROJ;
    __device__ __forceinline__ void operator()(const f32x4 (&acc)[2][2][4][2], const Unit& u, int wr, int wc, int fr, int fq) const {
        const int row0 = u.pm * BM + wr * 64 + fr, col0 = u.pn * BM + wc * 32 + 4 * fq;
#pragma unroll
        for (int ai = 0; ai < 2; ++ai)
#pragma unroll
            for (int m = 0; m < 4; ++m) { const size_t row = row0 + ai * HALF + m * 16;
#pragma unroll
                for (int bj = 0; bj < 2; ++bj)
#pragma unroll
                    for (int n = 0; n < 2; ++n) { const int c = col0 + bj * HALF + n * 16; const u32x2 g = *(const u32x2*)(PROJ + row * 5632 + 3584 + c); const f32x4 y = *(const f32x4*)(Y1 + row * 1024 + c); const f32x4 a = acc[ai][bj][m][n];
                        u32x2 w; w.x = cvt_pk_bf16(y[0] + a[0] * bflo(g.x), y[1] + a[1] * bfhi(g.x)); w.y = cvt_pk_bf16(y[2] + a[2] * bflo(g.y), y[3] + a[3] * bfhi(g.y));
                        *(u32x2*)(MG + row * 1024 + c) = w; } }
    }
};
struct EpiH1 { static constexpr bool PERM = false; float* H; const float* X;
    __device__ __forceinline__ void operator()(const f32x4 (&acc)[2][2][4][2], const Unit& u, int wr, int wc, int fr, int fq) const {
        const int row0 = u.pm * BM + wr * 64 + fr, col0 = u.pn * BM + wc * 32 + 4 * fq;
#pragma unroll
        for (int ai = 0; ai < 2; ++ai)
#pragma unroll
            for (int m = 0; m < 4; ++m) { const size_t row = row0 + ai * HALF + m * 16;
#pragma unroll
                for (int bj = 0; bj < 2; ++bj)
#pragma unroll
                    for (int n = 0; n < 2; ++n) { const size_t o = row * 1024 + col0 + bj * HALF + n * 16; *(f32x4*)(H + o) = *(const f32x4*)(X + o) + acc[ai][bj][m][n]; } }
    }
};
struct EpiPl { static constexpr bool PERM = false; float* H; const bf16_t* PLRAW; const float* plstat; const float* bg; const float* gpost;
    __device__ __forceinline__ void operator()(const f32x4 (&acc)[2][2][4][2], const Unit& u, int wr, int wc, int fr, int fq) const {
        const int row0 = u.pm * BM + wr * 64 + fr, col0 = u.pn * BM + wc * 32 + 4 * fq;
        f32x4 bv[2][2], gv[2][2];
#pragma unroll
        for (int bj = 0; bj < 2; ++bj)
#pragma unroll
            for (int n = 0; n < 2; ++n) { bv[bj][n] = *(const f32x4*)(bg + col0 + bj * HALF + n * 16); gv[bj][n] = *(const f32x4*)(gpost + col0 + bj * HALF + n * 16); }
#pragma unroll
        for (int ai = 0; ai < 2; ++ai)
#pragma unroll
            for (int m = 0; m < 4; ++m) { const size_t row = row0 + ai * HALF + m * 16; const float ps = plstat[row];
#pragma unroll
                for (int bj = 0; bj < 2; ++bj)
#pragma unroll
                    for (int n = 0; n < 2; ++n) { const size_t o = row * 1024 + col0 + bj * HALF + n * 16; const u32x2 p = *(const u32x2*)(PLRAW + o); const f32x4 h = *(const f32x4*)(H + o); const f32x4 a = acc[ai][bj][m][n] + bv[bj][n]; const f32x4 gp = gv[bj][n] * ps;
                        *(f32x4*)(H + o) = (f32x4){h[0] + fsig(a[0]) * bflo(p.x) * gp[0], h[1] + fsig(a[1]) * bfhi(p.x) * gp[1], h[2] + fsig(a[2]) * bflo(p.y) * gp[2], h[3] + fsig(a[3]) * bfhi(p.y) * gp[3]}; } }
    }
};

template <bool GATHER, class Epi, class Sched>
__device__ __forceinline__ void gemm_phase(LAS unsigned char* lds, const Gemm g, const Sched& S, const Epi& E) {
    const int tid = threadIdx.x, wid = __builtin_amdgcn_readfirstlane(tid >> 6), lane = tid & 63, wr = wid >> 2, wc = wid & 3, fr = lane & 15, fq = lane >> 4;
    const int K = g.K, nt = K / BK;
    unsigned voffA[2], voffB[2]; int RA[2], CA[2];
#pragma unroll
    for (int i = 0; i < 2; ++i) { int R, C; stage_rc(tid * 16 + i * 8192, R, C); const int Rb = Epi::PERM ? ((R & ~31) + perm32(R & 31)) : R;
        voffA[i] = (unsigned)(R * K + C) * 2u; voffB[i] = (unsigned)(Rb * K + C) * 2u; RA[i] = R; CA[i] = C; }
    const size_t kstep = (size_t)(BK * 2);
    const size_t hstep = (size_t)HALF * K * 2;
    const size_t hstepA = GATHER ? 0 : hstep;
    const size_t tstep = 2 * hstep;
    const unsigned ldsw = (unsigned)wid * 1024u;
    const int aoff = lds_byte(wr * 64 + fr, fq * 8), boff = lds_byte(wc * 32 + fr, fq * 8);
#define PG8_SA(b, h) (((b) * 2 + (h)) * HTB)
#define PG8_SB(b, h) ((4 + (b) * 2 + (h)) * HTB)
#define PG8_STAGE(bufoff, gbase, voff) do { _Pragma("unroll") for (int _i = 0; _i < 2; ++_i) \
        __builtin_amdgcn_global_load_lds((const unsigned*)((const char*)(gbase) + (voff)[_i]), (LAS unsigned*)(lds + (bufoff) + ldsw + _i * 8192), 16, 0, 0); } while (0)
#define PG8_STAGE_A(bufoff, gbase, vg, h) do { _Pragma("unroll") for (int _i = 0; _i < 2; ++_i) \
        __builtin_amdgcn_global_load_lds((const unsigned*)((const char*)(gbase) + (GATHER ? (vg)[h][_i] : voffA[_i])), (LAS unsigned*)(lds + (bufoff) + ldsw + _i * 8192), 16, 0, 0); } while (0)
#define PG8_LDA(dst, b, h) do { _Pragma("unroll") for (int m = 0; m < 4; ++m) _Pragma("unroll") for (int k = 0; k < 2; ++k) dst[m][k] = *(const LAS bf16x8*)(lds + PG8_SA(b, h) + aoff + m * 2048 + k * 1024); } while (0)
#define PG8_LDB(dst, b, h) do { _Pragma("unroll") for (int n = 0; n < 2; ++n) _Pragma("unroll") for (int k = 0; k < 2; ++k) dst[n][k] = *(const LAS bf16x8*)(lds + PG8_SB(b, h) + boff + n * 2048 + k * 1024); } while (0)
#define PG8_MMA(ai, bj, At, Bt) do { __builtin_amdgcn_s_setprio(1); _Pragma("unroll") for (int m = 0; m < 4; ++m) _Pragma("unroll") for (int n = 0; n < 2; ++n) _Pragma("unroll") for (int k = 0; k < 2; ++k) \
        acc[ai][bj][m][n] = __builtin_amdgcn_mfma_f32_16x16x32_bf16(Bt[n][k], At[m][k], acc[ai][bj][m][n], 0, 0, 0); __builtin_amdgcn_s_setprio(0); } while (0)
#define PG8_WAIT_V(n) asm volatile("s_waitcnt vmcnt(" #n ")" ::: "memory")
#define PG8_WAIT_L(n) asm volatile("s_waitcnt lgkmcnt(" #n ")" ::: "memory")
#define PG8_BAR __builtin_amdgcn_s_barrier()
#define PG8_SCHED __builtin_amdgcn_sched_barrier(0)
    Unit cur, nxt; int ui = 0;
    if (!S.next(0, cur)) return;
    f32x4 acc[2][2][4][2];
#pragma unroll
    for (int a = 0; a < 2; ++a)
#pragma unroll
        for (int b = 0; b < 2; ++b)
#pragma unroll
            for (int m = 0; m < 4; ++m)
#pragma unroll
                for (int n = 0; n < 2; ++n) acc[a][b][m][n] = (f32x4){0.f, 0.f, 0.f, 0.f};
    bf16x8 At[4][2], B0[2][2], B1[2][2];
    unsigned cvo[2][2] = {{0u, 0u}, {0u, 0u}}, nvo[2][2] = {{0u, 0u}, {0u, 0u}};
    if (GATHER) {
#pragma unroll
        for (int h = 0; h < 2; ++h)
#pragma unroll
            for (int i = 0; i < 2; ++i) { int tk, dm; S.gather_rows(cur, h * HALF + RA[i], tk, dm); cvo[h][i] = (unsigned)(tk * K + CA[i]) * 2u; }
    }
    const char* cA = (const char*)g.A + (GATHER ? (size_t)0 : (size_t)cur.pm * tstep);
    const char* cB = (const char*)g.Bt + ((size_t)cur.e * g.bt_estride) * 2 + (size_t)cur.pn * tstep;
    PG8_STAGE(PG8_SB(0, 0), cB, voffB); PG8_STAGE(PG8_SB(0, 1), cB + hstep, voffB); PG8_STAGE_A(PG8_SA(0, 0), cA, cvo, 0); PG8_STAGE_A(PG8_SA(0, 1), cA + hstepA, cvo, 1);
    if (wr == 1) PG8_BAR;
    PG8_WAIT_V(2); PG8_BAR;
    PG8_STAGE(PG8_SB(1, 0), cB + kstep, voffB); PG8_STAGE_A(PG8_SA(1, 0), cA + kstep, cvo, 0); PG8_STAGE(PG8_SB(1, 1), cB + hstep + kstep, voffB);
    PG8_WAIT_V(6); PG8_BAR;
    for (;;) {
        const bool has_next = S.next(ui + 1, nxt);
        const char* nA = has_next ? (const char*)g.A + (GATHER ? (size_t)0 : (size_t)nxt.pm * tstep) : cA;
        const char* nB = has_next ? (const char*)g.Bt + ((size_t)nxt.e * g.bt_estride) * 2 + (size_t)nxt.pn * tstep : cB;
        if (GATHER) {
#pragma unroll
            for (int h = 0; h < 2; ++h)
#pragma unroll
                for (int i = 0; i < 2; ++i) { if (has_next) { int tk, dm; S.gather_rows(nxt, h * HALF + RA[i], tk, dm); nvo[h][i] = (unsigned)(tk * K + CA[i]) * 2u; } else nvo[h][i] = cvo[h][i]; }
        }
        for (int t = 0; t < nt; t += 2) {
            const bool last = (t == nt - 2);
            const char* a1 = cA + (size_t)(t + 1) * kstep;
            const char* a2 = last ? nA : cA + (size_t)(t + 2) * kstep; const char* b2 = last ? nB : cB + (size_t)(t + 2) * kstep;
            const char* a3 = a2 + kstep; const char* b3 = b2 + kstep;
            unsigned svo[2][2];
#pragma unroll
            for (int h = 0; h < 2; ++h)
#pragma unroll
                for (int i = 0; i < 2; ++i) svo[h][i] = last ? nvo[h][i] : cvo[h][i];
            PG8_LDB(B0, 0, 0); PG8_LDB(B1, 0, 1); PG8_SCHED; PG8_LDA(At, 0, 0); PG8_STAGE_A(PG8_SA(1, 1), a1 + hstepA, cvo, 1);
            PG8_WAIT_V(8); PG8_WAIT_L(0); PG8_BAR; PG8_MMA(0, 0, At, B0); PG8_MMA(0, 1, At, B1); PG8_BAR; PG8_SCHED;
            PG8_LDA(At, 0, 1); PG8_STAGE(PG8_SB(0, 0), b2, voffB); PG8_STAGE(PG8_SB(0, 1), b2 + hstep, voffB); PG8_STAGE_A(PG8_SA(0, 0), a2, svo, 0);
            PG8_WAIT_V(8); PG8_WAIT_L(0); PG8_BAR; PG8_MMA(1, 0, At, B0); PG8_MMA(1, 1, At, B1); PG8_BAR; PG8_SCHED;
            PG8_LDB(B0, 1, 0); PG8_LDB(B1, 1, 1); PG8_SCHED; PG8_LDA(At, 1, 0); PG8_STAGE_A(PG8_SA(0, 1), a2 + hstepA, svo, 1);
            PG8_WAIT_V(8); PG8_WAIT_L(0); PG8_BAR; PG8_MMA(0, 0, At, B0); PG8_MMA(0, 1, At, B1); PG8_BAR; PG8_SCHED;
            PG8_LDA(At, 1, 1); PG8_STAGE(PG8_SB(1, 0), b3, voffB); PG8_STAGE(PG8_SB(1, 1), b3 + hstep, voffB); PG8_STAGE_A(PG8_SA(1, 0), a3, svo, 0);
            PG8_WAIT_V(8); PG8_WAIT_L(0); PG8_BAR; PG8_MMA(1, 0, At, B0); PG8_MMA(1, 1, At, B1); PG8_BAR; PG8_SCHED;
        }
        if (wr == 0) PG8_BAR;
        E(acc, cur, wr, wc, fr, fq);
        if (!has_next) break;
#pragma unroll
        for (int a = 0; a < 2; ++a)
#pragma unroll
            for (int b = 0; b < 2; ++b)
#pragma unroll
                for (int m = 0; m < 4; ++m)
#pragma unroll
                    for (int n = 0; n < 2; ++n) acc[a][b][m][n] = (f32x4){0.f, 0.f, 0.f, 0.f};
        cur = nxt; cA = nA; cB = nB; ++ui;
#pragma unroll
        for (int h = 0; h < 2; ++h)
#pragma unroll
            for (int i = 0; i < 2; ++i) cvo[h][i] = nvo[h][i];
        if (wr == 1) PG8_BAR;
    }
    PG8_WAIT_V(0);
    PG8_BAR;
#undef PG8_SA
#undef PG8_SB
#undef PG8_STAGE
#undef PG8_STAGE_A
#undef PG8_LDA
#undef PG8_LDB
#undef PG8_MMA
#undef PG8_WAIT_V
#undef PG8_WAIT_L
#undef PG8_BAR
#undef PG8_SCHED
}
}

constexpr int NG_AS = 132, NG_BS = 68;
template <bool DUAL, class ARow, class Epi>
__device__ __forceinline__ void ngemm_tile(LAS float* As, LAS float* Bs, LAS float* Bs2, const bf16* A, int lda, const ARow& arow,
                                           const bf16* Bt, int ldb, int brow0, int K, int tid, const Epi& epi) {
    const int ty = tid >> 4, tx = tid & 15;
    float acc[4][4], acc2[4][4];
#pragma unroll
    for (int i = 0; i < 4; ++i)
#pragma unroll
        for (int j = 0; j < 4; ++j) { acc[i][j] = 0.f; acc2[i][j] = 0.f; }
    const int lr = tid >> 2, lk = (tid & 3) * 8;
    const long ar = arow(lr);
    for (int k0 = 0; k0 < K; k0 += 32) {
        __syncthreads();
        {
            v4u v = (v4u){0u, 0u, 0u, 0u};
            if (ar >= 0) v = *(const v4u*)(A + (size_t)ar * lda + k0 + lk);
            const unsigned w[4] = {v.x, v.y, v.z, v.w};
#pragma unroll
            for (int j = 0; j < 4; ++j) { As[(lk + 2 * j) * NG_AS + lr] = __uint_as_float(w[j] << 16); As[(lk + 2 * j + 1) * NG_AS + lr] = __uint_as_float(w[j] & 0xffff0000u); }
        }
        if (tid < 256) {
            const v4u v = *(const v4u*)(Bt + (size_t)(brow0 + lr) * ldb + k0 + lk);
            const unsigned w[4] = {v.x, v.y, v.z, v.w};
#pragma unroll
            for (int j = 0; j < 4; ++j) { Bs[(lk + 2 * j) * NG_BS + lr] = __uint_as_float(w[j] << 16); Bs[(lk + 2 * j + 1) * NG_BS + lr] = __uint_as_float(w[j] & 0xffff0000u); }
        } else if (DUAL) {
            const int lr2 = lr - 64;
            const v4u v = *(const v4u*)(Bt + (size_t)(brow0 + 128 + lr2) * ldb + k0 + lk);
            const unsigned w[4] = {v.x, v.y, v.z, v.w};
#pragma unroll
            for (int j = 0; j < 4; ++j) { Bs2[(lk + 2 * j) * NG_BS + lr2] = __uint_as_float(w[j] << 16); Bs2[(lk + 2 * j + 1) * NG_BS + lr2] = __uint_as_float(w[j] & 0xffff0000u); }
        }
        __syncthreads();
#pragma unroll 8
        for (int k = 0; k < 32; ++k) {
            const f32x4 a = *(const LAS f32x4*)(As + k * NG_AS + ty * 4);
            const f32x4 b = *(const LAS f32x4*)(Bs + k * NG_BS + tx * 4);
#pragma unroll
            for (int i = 0; i < 4; ++i)
#pragma unroll
                for (int j = 0; j < 4; ++j) acc[i][j] += a[i] * b[j];
            if (DUAL) {
                const f32x4 b2 = *(const LAS f32x4*)(Bs2 + k * NG_BS + tx * 4);
#pragma unroll
                for (int i = 0; i < 4; ++i)
#pragma unroll
                    for (int j = 0; j < 4; ++j) acc2[i][j] += a[i] * b2[j];
            }
        }
    }
#pragma unroll
    for (int i = 0; i < 4; ++i)
#pragma unroll
        for (int j = 0; j < 4; ++j) epi(ty * 4 + i, tx * 4 + j, acc[i][j], acc2[i][j]);
}
#define NG_LDS(F) LAS float* As = (LAS float*)(F.lds); LAS float* Bs = As + 32 * NG_AS; LAS float* Bs2 = Bs + 32 * NG_BS;
struct ARowLin { long r0; __device__ __forceinline__ long operator()(int r) const { return r0 + r; } };

__device__ __forceinline__ void p0_transpose_item(const float* W, int K, int N, bf16* WT, long row_off, LAS float* scr, int kb, int nb, int lane) {
    const int k0 = 64 * kb, n0 = 32 * nb;
#pragma unroll 8
    for (int i = 0; i < 32; ++i) { const int kk = 2 * i + (lane >> 5); scr[kk * 33 + (lane & 31)] = W[(size_t)(k0 + kk) * N + n0 + (lane & 31)]; }
    LDS_WAIT(); asm volatile("" ::: "memory");
    const int c = lane & 7;
#pragma unroll
    for (int j = 0; j < 4; ++j) { const int n = (lane >> 3) + 8 * j; const LAS float* s = scr + (8 * c) * 33 + n;
        v4u o; o.x = pk2(s[0 * 33], s[1 * 33]); o.y = pk2(s[2 * 33], s[3 * 33]); o.z = pk2(s[4 * 33], s[5 * 33]); o.w = pk2(s[6 * 33], s[7 * 33]);
        *(GAS v4u*)(WT + (size_t)(row_off + n0 + n) * K + k0 + 8 * c) = o; }
    LDS_WAIT(); asm volatile("" ::: "memory");
}
__device__ __forceinline__ void rms_row_to_bf16(const float* xrow, const float* g, bf16* orow, int lane) {
    const GAS f32x4* xr = (const GAS f32x4*)xrow + lane; const GAS f32x4* gr = (const GAS f32x4*)g + lane;
    f32x4 v[4]; float s2 = 0.f;
#pragma unroll
    for (int j = 0; j < 4; ++j) { v[j] = xr[64 * j]; s2 += (v[j].x * v[j].x + v[j].y * v[j].y) + (v[j].z * v[j].z + v[j].w * v[j].w); }
    const float rstd = 1.f / sqrtf(wave_sum(s2) * (1.f / D) + EPS);
    GAS unsigned long long* o8 = (GAS unsigned long long*)orow + lane;
#pragma unroll
    for (int j = 0; j < 4; ++j) { const f32x4 gg = gr[64 * j];
        o8[64 * j] = (unsigned long long)pk2(v[j].x * rstd * gg.x, v[j].y * rstd * gg.y) | ((unsigned long long)pk2(v[j].z * rstd * gg.z, v[j].w * rstd * gg.w) << 32); }
}
__device__ __forceinline__ void p0_prologue(Frame& F, const Args& KA) {
    LAS float* scr = (LAS float*)(F.lds + F.wave * 16384);
    const int gw = F.bid * NWAVES + F.wave, NGW = F.G * NWAVES;
    constexpr int I_IN = (D / 64) * (NPROJ / 32), I_MG = (D / 64) * (NGATE / 32), I_LR = 8 * 2 * 4  ;
    constexpr int I_AO = (AW / 64) * (D / 32), I_LO = (LW / 64) * (D / 32), I_WO = (D / 64) * (D / 32), I_PG = I_WO, I_PP = (PLD / 64) * (D / 32);
    constexpr int I_GU1 = (D / 64) * (2 * DE / 32), I_DN1 = (DE / 64) * (D / 32);
    constexpr int NITEMS = I_IN + I_MG + 2 * I_LR + I_AO + I_LO + I_WO + I_PG + I_PP + NE * (I_GU1 + I_DN1);
    for (int it = gw; it < NITEMS; it += NGW) {
        int r = it;
        if (r < I_IN) { const int nblk = NPROJ / 32; p0_transpose_item(KA.in[3], D, NPROJ, WSP(bf16, WS_WIN), 0, scr, r / nblk, r % nblk, F.lane); continue; } r -= I_IN;
        if (r < I_MG) { const int nblk = NGATE / 32; p0_transpose_item(KA.in[13], D, NGATE, WSP(bf16, WS_WIN), NPROJ, scr, r / nblk, r % nblk, F.lane); continue; } r -= I_MG;
        if (r < 2 * I_LR) { const int which = r / I_LR; r %= I_LR; const int blk = r / 8, q = r % 8;
            p0_transpose_item(KA.in[which ? 8 : 6] + (size_t)blk * 128 * 128, 128, 128, WSP(bf16, which ? WS_WLRUX : WS_WLRUA) + (size_t)blk * 128 * 128, 0, scr, q / 4, q % 4, F.lane); continue; } r -= 2 * I_LR;
        if (r < I_AO) { const int nblk = D / 32; p0_transpose_item(KA.in[11], AW, D, WSP(bf16, WS_WATTO), 0, scr, r / nblk, r % nblk, F.lane); continue; } r -= I_AO;
        if (r < I_LO) { const int nblk = D / 32; p0_transpose_item(KA.in[12], LW, D, WSP(bf16, WS_WLRUO), 0, scr, r / nblk, r % nblk, F.lane); continue; } r -= I_LO;
        if (r < I_WO) { const int nblk = D / 32; p0_transpose_item(KA.in[15], D, D, WSP(bf16, WS_WOUT), 0, scr, r / nblk, r % nblk, F.lane); continue; } r -= I_WO;
        if (r < I_PG) { const int nblk = D / 32; p0_transpose_item(KA.in[24], D, D, WSP(bf16, WS_WPLG), 0, scr, r / nblk, r % nblk, F.lane); continue; } r -= I_PG;
        if (r < I_PP) { const int nblk = D / 32; p0_transpose_item(KA.in[26], PLD, D, WSP(bf16, WS_WPLP), 0, scr, r / nblk, r % nblk, F.lane); continue; } r -= I_PP;
        const int e = r / (I_GU1 + I_DN1); r %= (I_GU1 + I_DN1);
        if (r < I_GU1) { const int nblk = 2 * DE / 32, kb = r / nblk, nb = r % nblk, n0 = nb * 32;
            const int j0 = n0 % DE, isup = n0 / DE; const long dest = 256 * (j0 / 128) + (j0 % 128) + 128 * isup;
            p0_transpose_item(KA.in[19] + (size_t)e * D * 2 * DE, D, 2 * DE, WSP(bf16, WS_WGU) + (size_t)e * 2 * DE * D, dest - n0, scr, kb, nb, F.lane); continue; } r -= I_GU1;
        { const int nblk = D / 32; p0_transpose_item(KA.in[21] + (size_t)e * DE * D, DE, D, WSP(bf16, WS_WDN) + (size_t)e * D * DE, 0, scr, r / nblk, r % nblk, F.lane); }
    }
    for (int m = gw; m < M; m += NGW) rms_row_to_bf16(KA.in[0] + (size_t)m * D, KA.in[2], WSP(bf16, WS_XN) + (size_t)m * D, F.lane);
    { const size_t n4 = (size_t)M * PLD / 4; const GAS f32x4* src = (const GAS f32x4*)KA.in[1]; GAS unsigned long long* dst = (GAS unsigned long long*)WSP(bf16, WS_P16);
      for (size_t i = (size_t)F.bid * NTHREADS + F.tid; i < n4; i += (size_t)F.G * NTHREADS) { const f32x4 v = src[i]; dst[i] = (unsigned long long)pk2(v.x, v.y) | ((unsigned long long)pk2(v.z, v.w) << 32); } }
}

struct EpiProj { bf16* PROJ; const float* bmerge; int m0, n0;
    __device__ __forceinline__ void operator()(int r, int c, float a, float) const {
        const int n = n0 + c; float v;
        if (n < AW) v = a * 0.125f; else if (n < 3 * AW + LW) v = a; else if (n < NPROJ) v = gelu_tanh(a); else v = sigmoidf_(a + bmerge[n - NPROJ]);
        PROJ[(size_t)(m0 + r) * NIN + n] = (bf16)f2bf(v); } };
struct EpiPlain { bf16* O; int ldo, m0, n0;
    __device__ __forceinline__ void operator()(int r, int c, float a, float) const { O[(size_t)(m0 + r) * ldo + n0 + c] = (bf16)f2bf(a); } };
__device__ __forceinline__ void p1_proj(Frame& F, const Args& KA) {
    NG_LDS(F)
    constexpr int T1 = (M / 128) * (NIN / 64), T2 = (M / 128) * (D / 64);
    for (int t = F.bid; t < T1 + T2; t += F.G) {
        if (t < T1) { const int tm = t / (NIN / 64), tn = t % (NIN / 64);
            EpiProj E{WSP(bf16, WS_PROJ), KA.in[14], tm * 128, tn * 64};
            ngemm_tile<false>(As, Bs, Bs2, WSP(bf16, WS_XN), D, ARowLin{(long)tm * 128}, WSP(bf16, WS_WIN), D, tn * 64, D, F.tid, E);
        } else { const int u = t - T1, tm = u / (D / 64), tn = u % (D / 64);
            EpiPlain E{WSP(bf16, WS_PLRAW), D, tm * 128, tn * 64};
            ngemm_tile<false>(As, Bs, Bs2, WSP(bf16, WS_P16), PLD, ARowLin{(long)tm * 128}, WSP(bf16, WS_WPLP), PLD, tn * 64, PLD, F.tid, E);
        }
    }
}

__device__ __forceinline__ void p2_attn_naive(Frame& F, const Args& KA) {
    const bf16* PROJ = WSP(bf16, WS_PROJ); bf16* ATT = WSP(bf16, WS_ATT);
    const int gw = F.bid * NWAVES + F.wave, NGW = F.G * NWAVES;
    for (int item = gw; item < BATCH * NH * SEQ; item += NGW) {
        const int t = item % SEQ, bh = item / SEQ, h = bh % NH, b = bh / NH;
        const size_t row = (size_t)b * SEQ + t;
        const float qd = bf2f(PROJ[row * NIN + h * HD + F.lane]);
        float cum = 0.f, o = 0.f;
        for (int s = t - 1; s >= 0; --s) {
            const bf16* kr = PROJ + ((size_t)b * SEQ + s) * NIN + AW + h * HD;
            const float z = wave_sum(qd * bf2f(kr[F.lane]));
            const float vd = bf2f(kr[AW + F.lane]);
            o += __expf(logsigf_(z) + cum) * vd;
            cum += logsigf_(-z);
            if (cum < -110.f) break;
        }
        ATT[row * AW + h * HD + F.lane] = (bf16)f2bf(o);
    }
}
__device__ __forceinline__ void p2_conv_naive(Frame& F, const Args& KA) {
    const bf16* PROJ = WSP(bf16, WS_PROJ); bf16* UC = WSP(bf16, WS_HN);
    const float* cw = KA.in[4]; const float* cb = KA.in[5];
    for (size_t i = (size_t)F.bid * NTHREADS + F.tid; i < (size_t)M * LW; i += (size_t)F.G * NTHREADS) {
        const int c = (int)(i % LW); const size_t row = i / LW; const int t = (int)(row % SEQ);
        float a = cb[c];
#pragma unroll
        for (int j = 0; j < 4; ++j) { const int tt = t - 3 + j; if (tt >= 0) a += cw[j * LW + c] * bf2f(PROJ[(row - 3 + j) * NIN + 3 * AW + c]); }
        UC[i] = (bf16)f2bf(a);
    }
}
struct EpiLruA { float* AC; const float* ba; const float* lam; int m0, n0;
    __device__ __forceinline__ void operator()(int r, int c, float a, float) const { const int n = n0 + c;
        const float rr = sigmoidf_(a + ba[n]); AC[(size_t)(m0 + r) * LW + n] = 8.0f * rr * logsigf_(lam[n]); } };
struct EpiLruB { float* BC; const float* AC; const bf16* UC; const float* bx; int m0, n0;
    __device__ __forceinline__ void operator()(int r, int c, float a, float) const { const int n = n0 + c; const size_t o = (size_t)(m0 + r) * LW + n;
        const float ii = sigmoidf_(a + bx[n]); const float la = AC[o];
        BC[o] = sqrtf(-expm1f(2.0f * la)) * (ii * bf2f(UC[o])); } };
__device__ __forceinline__ void p3_lru_gates_naive(Frame& F, const Args& KA) {
    NG_LDS(F)
    constexpr int T = (M / 128) * (LW / 64);
    for (int t = F.bid; t < T; t += F.G) { const int tm = t / (LW / 64), tn = t % (LW / 64), blk = (tn * 64) / 128;
        const bf16* A = WSP(bf16, WS_HN) + blk * 128;
        { EpiLruA E{WSP(float, WS_Y1), KA.in[7], KA.in[10], tm * 128, tn * 64};
          ngemm_tile<false>(As, Bs, Bs2, A, LW, ARowLin{(long)tm * 128}, WSP(bf16, WS_WLRUA) + (size_t)blk * 128 * 128, 128, (tn * 64) % 128, 128, F.tid, E); }
        { EpiLruB E{WSP(float, WS_YROWS), WSP(float, WS_Y1), WSP(bf16, WS_HN), KA.in[9], tm * 128, tn * 64};
          ngemm_tile<false>(As, Bs, Bs2, A, LW, ARowLin{(long)tm * 128}, WSP(bf16, WS_WLRUX) + (size_t)blk * 128 * 128, 128, (tn * 64) % 128, 128, F.tid, E); }
    }
}
__device__ __forceinline__ void p3_scan_naive(Frame& F, const Args& KA) {
    const float* AC = WSP(float, WS_Y1); const float* BC = WSP(float, WS_YROWS); const bf16* PROJ = WSP(bf16, WS_PROJ); bf16* YPRE = WSP(bf16, WS_YPRE);
    const int g = F.bid * NTHREADS + F.tid;
    if (g < BATCH * LW) { const int b = g / LW, c = g % LW; float h = 0.f;
        for (int t = 0; t < SEQ; ++t) { const size_t o = ((size_t)b * SEQ + t) * LW + c;
            h = __expf(AC[o]) * h + BC[o];
            YPRE[o] = (bf16)f2bf(bf2f(PROJ[((size_t)b * SEQ + t) * NIN + 3 * AW + LW + c]) * h); } }
}
struct EpiY1 { float* Y1; const bf16* PROJ; int m0, n0;
    __device__ __forceinline__ void operator()(int r, int c, float a, float) const { const size_t row = m0 + r; const int n = n0 + c;
        Y1[row * D + n] = bf2f(PROJ[row * NIN + NPROJ + D + n]) * a; } };
struct EpiMerged { bf16* MG; const float* Y1; const bf16* PROJ; int m0, n0;
    __device__ __forceinline__ void operator()(int r, int c, float a, float) const { const size_t row = m0 + r; const int n = n0 + c;
        MG[row * D + n] = (bf16)f2bf(Y1[row * D + n] + bf2f(PROJ[row * NIN + NPROJ + n]) * a); } };
__device__ __forceinline__ void p4_mix(Frame& F, const Args& KA) {
    NG_LDS(F)
    constexpr int T = (M / 128) * (D / 64);
    for (int t = F.bid; t < T; t += F.G) { const int tm = t / (D / 64), tn = t % (D / 64);
        { EpiY1 E{WSP(float, WS_Y1), WSP(bf16, WS_PROJ), tm * 128, tn * 64};
          ngemm_tile<false>(As, Bs, Bs2, WSP(bf16, WS_YPRE), LW, ARowLin{(long)tm * 128}, WSP(bf16, WS_WLRUO), LW, tn * 64, LW, F.tid, E); }
        { EpiMerged E{WSP(bf16, WS_MERGED), WSP(float, WS_Y1), WSP(bf16, WS_PROJ), tm * 128, tn * 64};
          ngemm_tile<false>(As, Bs, Bs2, WSP(bf16, WS_ATT), AW, ARowLin{(long)tm * 128}, WSP(bf16, WS_WATTO), AW, tn * 64, AW, F.tid, E); }
    }
}
struct EpiH1 { float* H; const float* x; int m0, n0;
    __device__ __forceinline__ void operator()(int r, int c, float a, float) const { const size_t o = (size_t)(m0 + r) * D + n0 + c; H[o] = x[o] + a; } };
__device__ __forceinline__ void p5_out(Frame& F, const Args& KA) {
    NG_LDS(F)
    constexpr int T = (M / 128) * (D / 64);
    for (int t = F.bid; t < T; t += F.G) { const int tm = t / (D / 64), tn = t % (D / 64);
        EpiH1 E{F.out, KA.in[0], tm * 128, tn * 64};
        ngemm_tile<false>(As, Bs, Bs2, WSP(bf16, WS_MERGED), D, ARowLin{(long)tm * 128}, WSP(bf16, WS_WOUT), D, tn * 64, D, F.tid, E); }
}
__device__ __forceinline__ void p6_router(Frame& F, const Args& KA) {
    LAS float* xs = (LAS float*)F.lds;
    LAS float* part = xs + 16 * 1024;
    LAS int* hist = (LAS int*)(part + 8 * 16 * 32);
    LAS int* asgE = hist + 64;
    LAS int* asgR = asgE + 1024; LAS int* asgM = asgR + 1024; LAS float* asgG = (LAS float*)(asgM + 1024);
    const float* g = KA.in[16]; const float* Wr = KA.in[17]; const float* br = KA.in[18];
    const int e = F.lane & 31, half = F.lane >> 5, kb = F.wave * 128 + half * 64;
    float wreg[64];
#pragma unroll
    for (int kk = 0; kk < 64; ++kk) wreg[kk] = Wr[(size_t)(kb + kk) * NE + e];
    if (F.tid < 64) hist[F.tid] = 0;
    int nasg = 0;
    __syncthreads();
    for (int blk = F.bid; blk < M / 16; blk += F.G) {
        const int row0 = blk * 16;
#pragma unroll 1
        for (int rr = 0; rr < 2; ++rr) { const int r = F.wave * 2 + rr, m = row0 + r;
            const GAS f32x4* xr = (const GAS f32x4*)(F.out + (size_t)m * D) + F.lane; const GAS f32x4* gr = (const GAS f32x4*)g + F.lane;
            f32x4 v[4]; float s2 = 0.f;
#pragma unroll
            for (int j = 0; j < 4; ++j) { v[j] = xr[64 * j]; s2 += (v[j].x * v[j].x + v[j].y * v[j].y) + (v[j].z * v[j].z + v[j].w * v[j].w); }
            const float rstd = 1.f / sqrtf(wave_sum(s2) * (1.f / D) + EPS);
            GAS unsigned long long* o8 = (GAS unsigned long long*)(WSP(bf16, WS_XN) + (size_t)m * D) + F.lane;
#pragma unroll
            for (int j = 0; j < 4; ++j) { const f32x4 gg = gr[64 * j]; v[j].x *= rstd * gg.x; v[j].y *= rstd * gg.y; v[j].z *= rstd * gg.z; v[j].w *= rstd * gg.w;
                o8[64 * j] = (unsigned long long)pk2(v[j].x, v[j].y) | ((unsigned long long)pk2(v[j].z, v[j].w) << 32);
                *(LAS f32x4*)(xs + r * 1024 + 4 * (F.lane + 64 * j)) = v[j]; } }
        __syncthreads();
#pragma unroll 1
        for (int r = 0; r < 16; ++r) { float s = 0.f; const LAS f32x4* xp = (const LAS f32x4*)(xs + r * 1024 + kb);
#pragma unroll
            for (int q = 0; q < 16; ++q) { const f32x4 xv = xp[q]; s += xv.x * wreg[4 * q] + xv.y * wreg[4 * q + 1] + xv.z * wreg[4 * q + 2] + xv.w * wreg[4 * q + 3]; }
            s += __shfl_xor(s, 32);
            if (half == 0) part[(F.wave * 16 + r) * 32 + e] = s; }
        __syncthreads();
#pragma unroll 1
        for (int rr = 0; rr < 2; ++rr) { const int r = F.wave * 2 + rr, m = row0 + r;
            float lg = br[e];
#pragma unroll
            for (int w = 0; w < 8; ++w) lg += part[(w * 16 + r) * 32 + e];
            float tv[TOPK]; int te[TOPK];
#pragma unroll
            for (int k = 0; k < TOPK; ++k) { float bv = lg; int bi = e;
#pragma unroll
                for (int o = 1; o < 32; o <<= 1) { const float ov = __shfl_xor(bv, o); const int oi = __shfl_xor(bi, o); if (ov > bv || (ov == bv && oi < bi)) { bv = ov; bi = oi; } }
                tv[k] = bv; te[k] = bi; if (e == bi) lg = -INFINITY; }
            float den = 0.f, ex[TOPK];
#pragma unroll
            for (int k = 0; k < TOPK; ++k) { ex[k] = __expf(tv[k] - tv[0]); den += ex[k]; }
            if (F.lane < TOPK) { int ee = te[0]; float gt = ex[0];
#pragma unroll
                for (int k = 1; k < TOPK; ++k) if (F.lane == k) { ee = te[k]; gt = ex[k]; }
                const int rank = atomicAdd((int*)(hist + ee), 1);
                const int a = nasg + r * TOPK + F.lane;
                asgE[a] = ee; asgR[a] = rank; asgM[a] = m * TOPK + F.lane; asgG[a] = gt / den; } }
        nasg += 16 * TOPK;
        __syncthreads();
    }
    if (F.tid < NE) hist[32 + F.tid] = (int)atomicAdd((unsigned*)(F.ctl + CW_COUNTS + F.tid), (unsigned)hist[F.tid]);
    __syncthreads();
    int* tokE = (int*)(F.ws + WS_SMALL + SM_TOKE); int* tokS = (int*)(F.ws + WS_SMALL + SM_TOKSLOT); float* tokG = (float*)(F.ws + WS_SMALL + SM_TOKGATE);
    int* list = (int*)(F.ws + WS_SMALL + SM_LIST);
    for (int a = F.tid; a < nasg; a += NTHREADS) { const int ee = asgE[a], slot = hist[32 + ee] + asgR[a], mk = asgM[a];
        tokE[mk] = ee; tokS[mk] = slot; tokG[mk] = asgG[a]; list[(size_t)ee * M + slot] = mk / TOPK; }
}
__device__ __forceinline__ void moe_segments(Frame& F, LAS int* seg) {
    __syncthreads();
    if (F.tid == 0) { int acc = 0; for (int e = 0; e < NE; ++e) { const int c = (int)__hip_atomic_load(F.ctl + CW_COUNTS + e, RLX_AGENT); seg[e] = acc; seg[64 + e] = c; acc += (c + 255) & ~255; } seg[NE] = acc; }
    __syncthreads();
}
struct ARowGather { const int* list; int cnt; int l0; __device__ __forceinline__ long operator()(int r) const { const int l = l0 + r; return l < cnt ? (long)list[l] : -1L; } };
struct EpiSwiglu { bf16* H; const float* bgu; long row0; int j0;
    __device__ __forceinline__ void operator()(int r, int c, float ag, float au) const { const int j = j0 + c;
        float gate = ag + bgu[j], up = au + bgu[DE + j];
        gate = fminf(gate, 7.0f); up = fminf(fmaxf(up, -7.0f), 7.0f);
        const float glu = gate * sigmoidf_(gate * 1.702f);
        H[(size_t)(row0 + r) * DE + j] = (bf16)f2bf((up + 1.0f) * glu); } };
__device__ __forceinline__ void p7_moe_up(Frame& F, const Args& KA) {
    NG_LDS(F)
    LAS int* seg = (LAS int*)(F.lds + 65536);
    moe_segments(F, seg);
    const int total = seg[NE]; const int nmt = total / 128, T = nmt * (DE / 64);
    const int* list = (const int*)(F.ws + WS_SMALL + SM_LIST);
    for (int t = F.bid; t < T; t += F.G) { const int tm = t / (DE / 64), tn = t % (DE / 64); const int row0 = tm * 128;
        int e = 0;
#pragma unroll 1
        for (int q = 1; q < NE; ++q) if (seg[q] <= row0) e = q;
        const int cnt = seg[64 + e], l0 = row0 - seg[e];
        if (l0 >= cnt) continue;
        const int j0 = tn * 64; const int brow0 = 256 * (j0 / 128) + (j0 % 128);
        EpiSwiglu E{WSP(bf16, WS_HMOE), KA.in[20] + (size_t)e * 2 * DE, (long)row0, j0};
        ngemm_tile<true>(As, Bs, Bs2, WSP(bf16, WS_XN), D, ARowGather{list + (size_t)e * M, cnt, l0}, WSP(bf16, WS_WGU) + (size_t)e * 2 * DE * D, D, brow0, D, F.tid, E); }
}
struct EpiDown { bf16* Y; const float* bd; long row0; int n0;
    __device__ __forceinline__ void operator()(int r, int c, float a, float) const { Y[(size_t)(row0 + r) * D + n0 + c] = (bf16)f2bf(a + bd[n0 + c]); } };
__device__ __forceinline__ void p8_moe_down(Frame& F, const Args& KA) {
    NG_LDS(F)
    LAS int* seg = (LAS int*)(F.lds + 65536);
    moe_segments(F, seg);
    const int total = seg[NE]; const int nmt = total / 128, T = nmt * (D / 64);
    for (int t = F.bid; t < T; t += F.G) { const int tm = t / (D / 64), tn = t % (D / 64); const int row0 = tm * 128;
        int e = 0;
#pragma unroll 1
        for (int q = 1; q < NE; ++q) if (seg[q] <= row0) e = q;
        const int cnt = seg[64 + e], l0 = row0 - seg[e];
        if (l0 >= cnt) continue;
        EpiDown E{WSP(bf16, WS_YROWS), KA.in[22] + (size_t)e * D, (long)row0, tn * 64};
        ngemm_tile<false>(As, Bs, Bs2, WSP(bf16, WS_HMOE), DE, ARowLin{(long)row0}, WSP(bf16, WS_WDN) + (size_t)e * D * DE, DE, tn * 64, DE, F.tid, E); }
}
__device__ __forceinline__ void p9_combine(Frame& F, const Args& KA) {
    LAS int* seg = (LAS int*)(F.lds + 65536);
    moe_segments(F, seg);
    const int gw = F.bid * NWAVES + F.wave, NGW = F.G * NWAVES;
    const int* tokE = (const int*)(F.ws + WS_SMALL + SM_TOKE); const int* tokS = (const int*)(F.ws + WS_SMALL + SM_TOKSLOT); const float* tokG = (const float*)(F.ws + WS_SMALL + SM_TOKGATE);
    float* plstat = (float*)(F.ws + WS_SMALL + SM_PLSTAT);
    for (int m = gw; m < M; m += NGW) {
        GAS f32x4* hr = (GAS f32x4*)(F.out + (size_t)m * D) + F.lane;
        f32x4 v[4];
#pragma unroll
        for (int j = 0; j < 4; ++j) v[j] = hr[64 * j];
#pragma unroll
        for (int k = 0; k < TOPK; ++k) { const int e = tokE[m * TOPK + k]; const long row = seg[e] + tokS[m * TOPK + k]; const float gt = tokG[m * TOPK + k];
            const GAS unsigned long long* yr = (const GAS unsigned long long*)(WSP(bf16, WS_YROWS) + (size_t)row * D) + F.lane;
#pragma unroll
            for (int j = 0; j < 4; ++j) { const unsigned long long w = yr[64 * j]; const unsigned lo = (unsigned)w, hi = (unsigned)(w >> 32);
                v[j].x += gt * __uint_as_float(lo << 16); v[j].y += gt * __uint_as_float(lo & 0xffff0000u); v[j].z += gt * __uint_as_float(hi << 16); v[j].w += gt * __uint_as_float(hi & 0xffff0000u); } }
        float s2 = 0.f;
#pragma unroll
        for (int j = 0; j < 4; ++j) { hr[64 * j] = v[j]; s2 += (v[j].x * v[j].x + v[j].y * v[j].y) + (v[j].z * v[j].z + v[j].w * v[j].w); }
        const float rstd = 1.f / sqrtf(wave_sum(s2) * (1.f / D) + EPS);
        const GAS f32x4* gr = (const GAS f32x4*)KA.in[23] + F.lane;
        GAS unsigned long long* o8 = (GAS unsigned long long*)(WSP(bf16, WS_HN) + (size_t)m * D) + F.lane;
#pragma unroll
        for (int j = 0; j < 4; ++j) { const f32x4 gg = gr[64 * j];
            o8[64 * j] = (unsigned long long)pk2(v[j].x * rstd * gg.x, v[j].y * rstd * gg.y) | ((unsigned long long)pk2(v[j].z * rstd * gg.z, v[j].w * rstd * gg.w) << 32); }
        const GAS unsigned long long* pr = (const GAS unsigned long long*)(WSP(bf16, WS_PLRAW) + (size_t)m * D) + F.lane; float p2 = 0.f;
#pragma unroll
        for (int j = 0; j < 4; ++j) { const unsigned long long w = pr[64 * j]; const unsigned lo = (unsigned)w, hi = (unsigned)(w >> 32);
            const float a = __uint_as_float(lo << 16), b = __uint_as_float(lo & 0xffff0000u), c = __uint_as_float(hi << 16), d = __uint_as_float(hi & 0xffff0000u); p2 += (a * a + b * b) + (c * c + d * d); }
        const float prs = 1.f / sqrtf(wave_sum(p2) * (1.f / D) + EPS);
        if (F.lane == 0) plstat[m] = prs;
    }
}
struct EpiPl { float* H; const bf16* PLRAW; const float* plstat; const float* bg; const float* gpost; int m0, n0;
    __device__ __forceinline__ void operator()(int r, int c, float a, float) const { const size_t row = m0 + r; const int n = n0 + c; const size_t o = row * D + n;
        const float gate = sigmoidf_(a + bg[n]); const float pl = bf2f(PLRAW[o]) * plstat[row] * gpost[n]; H[o] = H[o] + gate * pl; } };
__device__ __forceinline__ void p10_pl(Frame& F, const Args& KA) {
    NG_LDS(F)
    constexpr int T = (M / 128) * (D / 64);
    for (int t = F.bid; t < T; t += F.G) { const int tm = t / (D / 64), tn = t % (D / 64);
        EpiPl E{F.out, WSP(bf16, WS_PLRAW), (const float*)(F.ws + WS_SMALL + SM_PLSTAT), KA.in[25], KA.in[27], tm * 128, tn * 64};
        ngemm_tile<false>(As, Bs, Bs2, WSP(bf16, WS_HN), D, ARowLin{(long)tm * 128}, WSP(bf16, WS_WPLG), D, tn * 64, D, F.tid, E); }
}
__device__ __forceinline__ void p11_final(Frame& F, const Args& KA) {
    const int gw = F.bid * NWAVES + F.wave, NGW = F.G * NWAVES;
    for (int m = gw; m < M; m += NGW) {
        GAS f32x4* hr = (GAS f32x4*)(F.out + (size_t)m * D) + F.lane; const GAS f32x4* gr = (const GAS f32x4*)KA.in[28] + F.lane;
        f32x4 v[4]; float s2 = 0.f;
#pragma unroll
        for (int j = 0; j < 4; ++j) { v[j] = hr[64 * j]; s2 += (v[j].x * v[j].x + v[j].y * v[j].y) + (v[j].z * v[j].z + v[j].w * v[j].w); }
        const float rstd = 1.f / sqrtf(wave_sum(s2) * (1.f / D) + EPS);
#pragma unroll
        for (int j = 0; j < 4; ++j) { const f32x4 gg = gr[64 * j]; hr[64 * j] = (f32x4){v[j].x * rstd * gg.x, v[j].y * rstd * gg.y, v[j].z * rstd * gg.z, v[j].w * rstd * gg.w}; }
    }
}


constexpr int SEG_OFF = LDSCTL_OFF + 1024;
__device__ __forceinline__ void f1_proj(Frame& F, const Args& KA) {
    { pg8::Gemm g{WSP(bf16, WS_XN), WSP(bf16, WS_WIN), D, 0}; pg8::StaticOrder S; S.init(M, NIN, F.G, F.bid);
      pg8::EpiProj E{WSP(bf16, WS_PROJ), KA.in[14]};
      pg8::gemm_phase<false>(F.lds, g, S, E); }
    { pg8::Gemm g{WSP(bf16, WS_P16), WSP(bf16, WS_WPLP), PLD, 0}; pg8::StaticOrder S; S.init(M, D, F.G, F.bid);
      pg8::EpiBf16 E{WSP(bf16, WS_PLRAW), D, nullptr, 0};
      pg8::gemm_phase<false>(F.lds, g, S, E); }
}
__device__ __forceinline__ void f4_mix(Frame& F, const Args& KA) {
    { pg8::Gemm g{WSP(bf16, WS_YPRE), WSP(bf16, WS_WLRUO), LW, 0}; pg8::StaticOrder S; S.init(M, D, F.G, F.bid);
      pg8::EpiY1 E{WSP(float, WS_Y1), WSP(bf16, WS_PROJ)};
      pg8::gemm_phase<false>(F.lds, g, S, E); }
    { pg8::Gemm g{WSP(bf16, WS_ATT), WSP(bf16, WS_WATTO), AW, 0}; pg8::StaticOrder S; S.init(M, D, F.G, F.bid);
      pg8::EpiMerged E{WSP(bf16, WS_MERGED), WSP(float, WS_Y1), WSP(bf16, WS_PROJ)};
      pg8::gemm_phase<false>(F.lds, g, S, E); }
}
__device__ __forceinline__ void f5_out(Frame& F, const Args& KA) {
    pg8::Gemm g{WSP(bf16, WS_MERGED), WSP(bf16, WS_WOUT), D, 0}; pg8::StaticOrder S; S.init(M, D, F.G, F.bid);
    pg8::EpiH1 E{F.out, KA.in[0]};
    pg8::gemm_phase<false>(F.lds, g, S, E);
}
__device__ __forceinline__ void f7_moe_up(Frame& F, const Args& KA) {
    LAS int* seg = (LAS int*)(F.lds + SEG_OFF);
    moe_segments(F, seg);
    pg8::Gemm g{WSP(bf16, WS_XN), WSP(bf16, WS_WGU), D, (size_t)2 * DE * D}; pg8::MoeOrder S; S.init(seg, (const int*)(F.ws + WS_SMALL + SM_LIST), 2 * DE, F.G, F.bid);
    pg8::EpiSwiglu E{WSP(bf16, WS_HMOE), KA.in[20]};
    pg8::gemm_phase<true>(F.lds, g, S, E);
}
__device__ __forceinline__ void f8_moe_down(Frame& F, const Args& KA) {
    LAS int* seg = (LAS int*)(F.lds + SEG_OFF);
    moe_segments(F, seg);
    pg8::Gemm g{WSP(bf16, WS_HMOE), WSP(bf16, WS_WDN), DE, (size_t)D * DE}; pg8::MoeOrder S; S.init(seg, (const int*)(F.ws + WS_SMALL + SM_LIST), D, F.G, F.bid);
    pg8::EpiBf16 E{WSP(bf16, WS_YROWS), D, KA.in[22], D};
    pg8::gemm_phase<false>(F.lds, g, S, E);
}
__device__ __forceinline__ void f10_pl(Frame& F, const Args& KA) {
    pg8::Gemm g{WSP(bf16, WS_HN), WSP(bf16, WS_WPLG), D, 0}; pg8::StaticOrder S; S.init(M, D, F.G, F.bid);
    pg8::EpiPl E{F.out, WSP(bf16, WS_PLRAW), (const float*)(F.ws + WS_SMALL + SM_PLSTAT), KA.in[25], KA.in[27]};
    pg8::gemm_phase<false>(F.lds, g, S, E);
}


constexpr int LRU_CH = 512, LRU_NCH = SEQ / LRU_CH;
constexpr size_t SM_PEND = 4 * MiB - 512 * 1024, SM_HEND = SM_PEND + 128 * 1024;
constexpr int L_UA = 0, L_UASTR = 272, L_SA = 17408, L_SB = L_SA + 32768, L_QE = L_SB + 32768, L_RUN = L_QE + 4096, L_END = L_RUN + 1024;
typedef short bf16x8_t __attribute__((ext_vector_type(8)));
__device__ __forceinline__ void lru1_unit(Frame& F, const Args& KA, int unit) {
    const int b = unit >> 7, n = (unit >> 4) & 7, chunk = unit & 15;
    const int ch0 = n * 128;
    const bf16* PROJ = WSP(bf16, WS_PROJ);
    LAS unsigned char* L = F.lds;
    LAS float* SA = (LAS float*)(L + L_SA); LAS float* SB = (LAS float*)(L + L_SB); LAS float* QE = (LAS float*)(L + L_QE); LAS float* RUN = (LAS float*)(L + L_RUN);
    const int fr = F.lane & 15, fq = F.lane >> 4;
    bf16x8_t bA[4], bX[4];
    { const bf16* wa = WSP(bf16, WS_WLRUA) + (size_t)n * 128 * 128 + (size_t)(16 * F.wave + fr) * 128 + 8 * fq;
      const bf16* wx = WSP(bf16, WS_WLRUX) + (size_t)n * 128 * 128 + (size_t)(16 * F.wave + fr) * 128 + 8 * fq;
#pragma unroll
      for (int ks = 0; ks < 4; ++ks) { bA[ks] = *(const bf16x8_t*)(wa + 32 * ks); bX[ks] = *(const bf16x8_t*)(wx + 32 * ks); } }
    const int cc = ch0 + 16 * F.wave + fr;
    const float ba_c = KA.in[7][cc], bx_c = KA.in[9][cc], ls8 = 8.0f * logsigf_(KA.in[10][cc]);
    const int cs = (F.tid & 15) * 8, cr = F.tid >> 4;
    float cw[4][8], cb[8];
#pragma unroll
    for (int i = 0; i < 8; ++i) { cb[i] = KA.in[5][ch0 + cs + i];
#pragma unroll
        for (int j = 0; j < 4; ++j) cw[j][i] = KA.in[4][j * LW + ch0 + cs + i]; }
    if (F.tid < 128) { RUN[F.tid] = 1.0f; RUN[128 + F.tid] = 0.0f; }
    const int sc = F.tid & 127, sq = F.tid >> 7;
    bf16* HLOC = WSP(bf16, WS_HLOC); bf16* PCUM = WSP(bf16, WS_PCUM);
#pragma unroll 1
    for (int st = 0; st < LRU_CH / 64; ++st) {
        const int t0 = chunk * LRU_CH + st * 64;
        __syncthreads();
#pragma unroll
        for (int ps = 0; ps < 2; ++ps) { const int r = cr + 32 * ps, t = t0 + r;
            float o[8];
#pragma unroll
            for (int i = 0; i < 8; ++i) o[i] = cb[i];
#pragma unroll
            for (int j = 0; j < 4; ++j) { const int tt = t - 3 + j;
                if (tt >= 0) { const v4u u = *(const v4u*)(PROJ + ((size_t)b * SEQ + tt) * NIN + 3 * AW + ch0 + cs);
                    o[0] += cw[j][0] * pg8::bflo(u.x); o[1] += cw[j][1] * pg8::bfhi(u.x); o[2] += cw[j][2] * pg8::bflo(u.y); o[3] += cw[j][3] * pg8::bfhi(u.y);
                    o[4] += cw[j][4] * pg8::bflo(u.z); o[5] += cw[j][5] * pg8::bfhi(u.z); o[6] += cw[j][6] * pg8::bflo(u.w); o[7] += cw[j][7] * pg8::bfhi(u.w); } }
            v4u w; w.x = pk2(o[0], o[1]); w.y = pk2(o[2], o[3]); w.z = pk2(o[4], o[5]); w.w = pk2(o[6], o[7]);
            *(LAS v4u*)(L + L_UA + r * L_UASTR + cs * 2) = w; }
        __syncthreads();
        f32x4 accA[4], accX[4];
#pragma unroll
        for (int m = 0; m < 4; ++m) { accA[m] = (f32x4){0.f, 0.f, 0.f, 0.f}; accX[m] = (f32x4){0.f, 0.f, 0.f, 0.f}; }
#pragma unroll
        for (int m = 0; m < 4; ++m)
#pragma unroll
            for (int ks = 0; ks < 4; ++ks) { const bf16x8_t af = *(const LAS bf16x8_t*)(L + L_UA + (16 * m + fr) * L_UASTR + (32 * ks + 8 * fq) * 2);
                accA[m] = __builtin_amdgcn_mfma_f32_16x16x32_bf16(af, bA[ks], accA[m], 0, 0, 0);
                accX[m] = __builtin_amdgcn_mfma_f32_16x16x32_bf16(af, bX[ks], accX[m], 0, 0, 0); }
#pragma unroll
        for (int m = 0; m < 4; ++m)
#pragma unroll
            for (int i = 0; i < 4; ++i) { const int row = 16 * m + 4 * fq + i; const int cl = 16 * F.wave + fr;
                const float rr = pg8::fsig(accA[m][i] + ba_c), ii = pg8::fsig(accX[m][i] + bx_c);
                const float la = ls8 * rr, x2 = 2.0f * la;
                const float a = __expf(la);
                const float om = (x2 > -0.03f) ? -x2 * (1.0f + x2 * (0.5f + x2 * (1.0f / 6.0f))) : 1.0f - __expf(x2);
                const float uc = bf2f(*(const LAS bf16*)(L + L_UA + row * L_UASTR + cl * 2));
                SA[row * 128 + cl] = a; SB[row * 128 + cl] = sqrtf(om) * ii * uc; }
        __syncthreads();
        { float P = 1.0f, H = 0.0f;
#pragma unroll
          for (int r = 0; r < 16; ++r) { const int o = (16 * sq + r) * 128 + sc; const float a = SA[o], bb = SB[o]; H = a * H + bb; P = P * a; SA[o] = P; SB[o] = H; }
          QE[sq * 128 + sc] = P; QE[512 + sq * 128 + sc] = H; }
        __syncthreads();
        { float cp = RUN[sc], ch = RUN[128 + sc];
#pragma unroll
          for (int q = 0; q < 3; ++q) if (q < sq) { const float pe = QE[q * 128 + sc], he = QE[512 + q * 128 + sc]; ch = he + pe * ch; cp = cp * pe; }
          const size_t g0 = ((size_t)b * SEQ + t0 + 16 * sq) * LW + ch0 + sc;
#pragma unroll
          for (int r = 0; r < 16; ++r) { const int o = (16 * sq + r) * 128 + sc; const float p = SA[o], h = SB[o];
              HLOC[g0 + (size_t)r * LW] = (bf16)f2bf(h + p * ch); PCUM[g0 + (size_t)r * LW] = (bf16)f2bf(p * cp); }
          __syncthreads();
          if (sq == 3) { const float pe = QE[3 * 128 + sc], he = QE[512 + 3 * 128 + sc]; RUN[sc] = cp * pe; RUN[128 + sc] = he + pe * ch; } }
    }
    __syncthreads();
    if (F.tid < 128) { float* pend = (float*)(F.ws + WS_SMALL + SM_PEND); float* hend = (float*)(F.ws + WS_SMALL + SM_HEND);
        const size_t o = ((size_t)b * LRU_NCH + chunk) * LW + ch0 + F.tid; pend[o] = RUN[F.tid]; hend[o] = RUN[128 + F.tid]; }
    __syncthreads();
}
__device__ __forceinline__ void f2_lru1(Frame& F, const Args& KA) { for (int u = F.bid; u < BATCH * 8 * LRU_NCH; u += F.G) lru1_unit(F, KA, u); }
__device__ __forceinline__ void f3_lru2(Frame& F, const Args& KA) {
    LAS float* carry = (LAS float*)F.lds;
    const float* pend = (const float*)(F.ws + WS_SMALL + SM_PEND); const float* hend = (const float*)(F.ws + WS_SMALL + SM_HEND);
    const bf16* PROJ = WSP(bf16, WS_PROJ); const bf16* HLOC = WSP(bf16, WS_HLOC); const bf16* PCUM = WSP(bf16, WS_PCUM); bf16* YPRE = WSP(bf16, WS_YPRE);
    for (int it = F.bid; it < BATCH * LRU_NCH * 8; it += F.G) { const int part = it & 7, bc = it >> 3, b = bc / LRU_NCH, chunk = bc % LRU_NCH;
        __syncthreads();
#pragma unroll
        for (int k = 0; k < 2; ++k) { const int c = F.tid + 512 * k; float ch = 0.f;
            for (int j = 0; j < chunk; ++j) { const size_t o = ((size_t)b * LRU_NCH + j) * LW + c; ch = hend[o] + pend[o] * ch; }
            carry[c] = ch; }
        __syncthreads();
        const int c0 = (F.lane & 63) * 16;
#pragma unroll 1
        for (int rr = 0; rr < 8; ++rr) { const int t = chunk * LRU_CH + part * 64 + rr * 8 + F.wave; const size_t row = (size_t)b * SEQ + t;
#pragma unroll
            for (int hh = 0; hh < 2; ++hh) { const int c = c0 + 8 * hh;
                const v4u h = *(const v4u*)(HLOC + row * LW + c), p = *(const v4u*)(PCUM + row * LW + c), gg = *(const v4u*)(PROJ + row * NIN + 3 * AW + LW + c);
                const f32x4 ca = *(const LAS f32x4*)(carry + c), cb2 = *(const LAS f32x4*)(carry + c + 4);
                v4u o;
                o.x = pk2(pg8::bflo(gg.x) * (pg8::bflo(h.x) + pg8::bflo(p.x) * ca[0]), pg8::bfhi(gg.x) * (pg8::bfhi(h.x) + pg8::bfhi(p.x) * ca[1]));
                o.y = pk2(pg8::bflo(gg.y) * (pg8::bflo(h.y) + pg8::bflo(p.y) * ca[2]), pg8::bfhi(gg.y) * (pg8::bfhi(h.y) + pg8::bfhi(p.y) * ca[3]));
                o.z = pk2(pg8::bflo(gg.z) * (pg8::bflo(h.z) + pg8::bflo(p.z) * cb2[0]), pg8::bfhi(gg.z) * (pg8::bfhi(h.z) + pg8::bfhi(p.z) * cb2[1]));
                o.w = pk2(pg8::bflo(gg.w) * (pg8::bflo(h.w) + pg8::bflo(p.w) * cb2[2]), pg8::bfhi(gg.w) * (pg8::bfhi(h.w) + pg8::bfhi(p.w) * cb2[3]));
                *(v4u*)(YPRE + row * LW + c) = o; } }
    }
}


namespace sba {
typedef short bf16x8 __attribute__((ext_vector_type(8)));
typedef short s16x4 __attribute__((ext_vector_type(4)));
typedef float f32x16 __attribute__((ext_vector_type(16)));
typedef unsigned u32x4 __attribute__((ext_vector_type(4)));
typedef float f32x2_t __attribute__((ext_vector_type(2))); typedef __bf16 bf16x2_t __attribute__((ext_vector_type(2)));
constexpr int PITCH = NIN, SLOTB = 8192;
constexpr int A_K = 0, A_V = 2 * SLOTB, A_FLAG = 4 * SLOTB, A_OST = A_FLAG + 256, A_END = A_OST + 8 * 4096;
constexpr float CUM_DEAD = -160.0f;
__device__ __forceinline__ int crow(int r, int hi) { return (r & 3) + 8 * (r >> 2) + 4 * hi; }
__device__ __forceinline__ void glds16(const void* gsrc, unsigned lds_dst) { unsigned keep;
    asm volatile("s_mov_b32 %0, m0\n\ts_mov_b32 m0, %2\n\ts_nop 0\n\tglobal_load_lds_dwordx4 %1, off\n\ts_mov_b32 m0, %0" : "=&s"(keep) : "v"(gsrc), "s"(lds_dst) : "memory"); }
__device__ __forceinline__ unsigned cvtpk_s(float lo, float hi) { f32x2_t v = {lo, hi}; bf16x2_t b = __builtin_convertvector(v, bf16x2_t); return __builtin_bit_cast(unsigned, b); }
__device__ __forceinline__ void qkt(f32x16& p0, f32x16& p1, const LAS char* Kslot, const bf16x8* qr, int r32, int hi) {
    const LAS char* kb = Kslot + hi * 1024 + r32 * 16;
    f32x16 z = {};
#pragma unroll
    for (int d0 = 0; d0 < 4; ++d0) {
        const bf16x8 b0 = *(const LAS bf16x8*)(kb + d0 * 2048);
        const bf16x8 b1 = *(const LAS bf16x8*)(kb + d0 * 2048 + 512);
        if (d0 == 0) { p0 = __builtin_amdgcn_mfma_f32_32x32x16_bf16(b0, qr[0], z, 0, 0, 0); p1 = __builtin_amdgcn_mfma_f32_32x32x16_bf16(b1, qr[0], z, 0, 0, 0); }
        else { p0 = __builtin_amdgcn_mfma_f32_32x32x16_bf16(b0, qr[d0], p0, 0, 0, 0); p1 = __builtin_amdgcn_mfma_f32_32x32x16_bf16(b1, qr[d0], p1, 0, 0, 0); } }
}
__device__ __forceinline__ void pv(f32x16* o, int vb, bf16x8 pa0, bf16x8 pa1, bf16x8 pa2, bf16x8 pa3) {
#pragma unroll
    for (int d0 = 0; d0 < 2; ++d0) { s16x4 lo[4], hi[4];
#pragma unroll
        for (int ks = 0; ks < 4; ++ks) {
            asm volatile("ds_read_b64_tr_b16 %0,%1 offset:%c2" : "=&v"(lo[ks]) : "v"(vb), "i"(d0 * 4096 + ks * 1024) : "memory");
            asm volatile("ds_read_b64_tr_b16 %0,%1 offset:%c2" : "=&v"(hi[ks]) : "v"(vb), "i"(d0 * 4096 + ks * 1024 + 512) : "memory"); }
        asm volatile("s_waitcnt lgkmcnt(0)" ::: "memory"); __builtin_amdgcn_sched_barrier(0);
#define SBA_PK(k) (bf16x8){lo[k][0], lo[k][1], lo[k][2], lo[k][3], hi[k][0], hi[k][1], hi[k][2], hi[k][3]}
        o[d0] = __builtin_amdgcn_mfma_f32_32x32x16_bf16(pa0, SBA_PK(0), o[d0], 0, 0, 0);
        o[d0] = __builtin_amdgcn_mfma_f32_32x32x16_bf16(pa1, SBA_PK(1), o[d0], 0, 0, 0);
        o[d0] = __builtin_amdgcn_mfma_f32_32x32x16_bf16(pa2, SBA_PK(2), o[d0], 0, 0, 0);
        o[d0] = __builtin_amdgcn_mfma_f32_32x32x16_bf16(pa3, SBA_PK(3), o[d0], 0, 0, 0);
#undef SBA_PK
    }
}
__device__ __forceinline__ float block_weights(f32x16& z, float base, int hi, bool need_mask, int kv0  , int qabs) {
    float L[16];
#pragma unroll
    for (int r = 0; r < 16; ++r) { const float zz = z[r]; const float e = __builtin_amdgcn_exp2f(-fabsf(zz)); const float l = __builtin_amdgcn_logf(1.0f + e);
        L[r] = -(fmaxf(zz, 0.f) + l); z[r] = fminf(zz, 0.f) - l; }
    if (need_mask) {
#pragma unroll
        for (int r = 0; r < 16; ++r) { const int kv = kv0 + (r & 3) + 8 * (r >> 2); if (kv >= qabs) { L[r] = 0.f; z[r] = -INFINITY; } } }
    float ex[16], both[4], othm[4];
#pragma unroll
    for (int G = 0; G < 4; ++G) { ex[4 * G + 3] = 0.f; ex[4 * G + 2] = L[4 * G + 3]; ex[4 * G + 1] = ex[4 * G + 2] + L[4 * G + 2]; ex[4 * G] = ex[4 * G + 1] + L[4 * G + 1];
        const float tot = ex[4 * G] + L[4 * G];
        auto rr = __builtin_amdgcn_permlane32_swap(__float_as_uint(tot), __float_as_uint(tot), false, false);
        const float tl = __uint_as_float(rr[0]), th = __uint_as_float(rr[1]);
        both[G] = tl + th; othm[G] = hi ? 0.f : th; }
    float sfx[4]; sfx[3] = 0.f; sfx[2] = both[3]; sfx[1] = sfx[2] + both[2]; sfx[0] = sfx[1] + both[1];
#pragma unroll
    for (int G = 0; G < 4; ++G) { const float bs = base + sfx[G] + othm[G];
#pragma unroll
        for (int i = 0; i < 4; ++i) z[4 * G + i] = __builtin_amdgcn_exp2f(z[4 * G + i] + ex[4 * G + i] + bs); }
    return sfx[0] + both[0];
}
__device__ __forceinline__ void attn_unit(int b, int h, int qb, const bf16* PROJ, bf16* ATT, LAS unsigned char* lds) {
    const int tid = threadIdx.x, lane = tid & 63, r32 = lane & 31, hi = lane >> 5; const int wid = __builtin_amdgcn_readfirstlane(tid >> 6);
    const long rowbase = (long)b * SEQ; const int q0 = qb * 256;
    const bf16* Qw = PROJ + (rowbase + q0 + wid * 32) * PITCH + h * HD;
    const bf16* Kh = PROJ + rowbase * PITCH + AW + h * HD; const bf16* Vh = Kh + AW;
    const unsigned lds0 = (unsigned)(uintptr_t)lds;
    const bf16* ksrc = Kh + (long)lane * PITCH + wid * 8;
    const bf16* vsrc = Vh + (long)(16 * (wid & 3) + (lane >> 2)) * PITCH + (wid >> 2) * 32 + (lane & 3) * 8;
    const unsigned kdst = lds0 + A_K + wid * 1024, vdst = lds0 + A_V + wid * 1024;
#define SBA_DMA(t, slot) do { glds16(ksrc + (long)(t) * 64 * PITCH, (unsigned)__builtin_amdgcn_readfirstlane(kdst + (slot))); glds16(vsrc + (long)(t) * 64 * PITCH, (unsigned)__builtin_amdgcn_readfirstlane(vdst + (slot))); } while (0)
    const int vb0 = (int)(lds0 + A_V) + ((lane >> 4) & 1) * 32 + (lane & 3) * 8 + (4 * hi + ((lane & 15) >> 2)) * 64;
    volatile LAS int* wflag = (volatile LAS int*)(lds + A_FLAG);
    const int T0 = 4 * qb + 3;
    SBA_DMA(T0, 0);
    bf16x8 qr[4];
#pragma unroll
    for (int d0 = 0; d0 < 4; ++d0) qr[d0] = *(const bf16x8*)(Qw + (long)r32 * PITCH + d0 * 16 + hi * 8);
    f32x16 o[2]; o[0] = f32x16{}; o[1] = f32x16{};
    float cum = 0.f; bool dead = false;
    const int qabs = q0 + wid * 32 + r32, qmin = q0 + wid * 32, qmax = qmin + 31;
    asm volatile("s_waitcnt vmcnt(0)" ::: "memory"); __builtin_amdgcn_s_barrier();
    int slot = 0;
#pragma unroll 1
    for (int jt = T0, step = 0; jt >= 0; --jt, ++step) {
        if (jt > 0) SBA_DMA(jt - 1, slot ^ SLOTB);
        const int k0 = jt * 64;
        if (!dead && k0 < qmax) {
            const bool need_mask = (k0 + 63 >= qmin);
            f32x16 p0, p1;
            qkt(p0, p1, (const LAS char*)(lds + A_K + slot), qr, r32, hi);
            const float t1 = block_weights(p1, cum, hi, need_mask, k0 + 32 + 4 * hi, qabs);
            const float t0 = block_weights(p0, cum + t1, hi, need_mask, k0 + 4 * hi, qabs);
            cum += t0 + t1;
            u32x4 w0, w1, w2, w3;
            w0 = (u32x4){cvtpk_s(p0[0], p0[1]), cvtpk_s(p0[2], p0[3]), cvtpk_s(p0[4], p0[5]), cvtpk_s(p0[6], p0[7])};
            w1 = (u32x4){cvtpk_s(p0[8], p0[9]), cvtpk_s(p0[10], p0[11]), cvtpk_s(p0[12], p0[13]), cvtpk_s(p0[14], p0[15])};
            w2 = (u32x4){cvtpk_s(p1[0], p1[1]), cvtpk_s(p1[2], p1[3]), cvtpk_s(p1[4], p1[5]), cvtpk_s(p1[6], p1[7])};
            w3 = (u32x4){cvtpk_s(p1[8], p1[9]), cvtpk_s(p1[10], p1[11]), cvtpk_s(p1[12], p1[13]), cvtpk_s(p1[14], p1[15])};
            pv(o, vb0 + slot, __builtin_bit_cast(bf16x8, w0), __builtin_bit_cast(bf16x8, w1), __builtin_bit_cast(bf16x8, w2), __builtin_bit_cast(bf16x8, w3));
            dead = __all(cum < CUM_DEAD);
        }
        if (lane == 0) wflag[(step & 1) * 8 + wid] = dead ? 1 : 0;
        asm volatile("s_waitcnt vmcnt(0) lgkmcnt(0)" ::: "memory"); __builtin_amdgcn_s_barrier();
        int nd = 0;
#pragma unroll
        for (int w = 0; w < 8; ++w) nd += wflag[(step & 1) * 8 + w];
        if (nd == 8) break;
        slot ^= SLOTB;
    }
#undef SBA_DMA
    {   LAS bf16* stg = (LAS bf16*)(lds + A_OST) + wid * 2048;
#pragma unroll
        for (int r = 0; r < 16; ++r) { const int orow = crow(r, hi);
#pragma unroll
            for (int d0 = 0; d0 < 2; ++d0) stg[orow * 64 + d0 * 32 + r32] = (bf16)f2bf(o[d0][r]); }
        asm volatile("s_waitcnt lgkmcnt(0)" ::: "memory");
        bf16* Ow = ATT + (rowbase + q0 + wid * 32) * AW + h * HD;
#pragma unroll
        for (int i = 0; i < 4; ++i) { const int row = i * 8 + (lane >> 3), ch = lane & 7; const u32x4 v = *(const LAS u32x4*)(stg + row * 64 + ch * 8); *(u32x4*)(Ow + (long)row * AW + ch * 8) = v; } }
    asm volatile("s_waitcnt lgkmcnt(0)" ::: "memory"); __builtin_amdgcn_s_barrier();
}
}
__device__ __forceinline__ void f2_attn(Frame& F, const Args& KA) {
    for (int u = F.bid; u < BATCH * NH * 32; u += F.G) sba::attn_unit(u >> 8, (u >> 5) & 7, u & 31, WSP(bf16, WS_PROJ), WSP(bf16, WS_ATT), F.lds);
}

__global__ void __launch_bounds__(NTHREADS, 2) hyb_fwd(Args args) {
    extern __shared__ __attribute__((aligned(16))) unsigned char lds[];
    Frame F;
    F.lds = (LAS unsigned char*)lds; F.MISC = (volatile LAS unsigned*)(F.lds + MISC_OFF);
    F.tid = threadIdx.x; F.lane = F.tid & 63; F.wave = __builtin_amdgcn_readfirstlane(F.tid >> 6);
    F.G = gridDim.x; F.bid = blockIdx.x;
    F.ws = args.ws; F.ctl = (gu32*)(args.ws + WS_CTL); F.out = args.out;
    for (int u = F.tid; u < (LDS_BYTES - LDSCTL_OFF) / 4; u += NTHREADS) ((LAS unsigned*)(F.lds + LDSCTL_OFF))[u] = 0u;
    __syncthreads();
    const int lo = args.ph_lo, hi = args.ph_hi;
    const bool multi = (hi - lo) > 1;
    XcdBarrier bar; bar.bar = (unsigned*)(F.ctl + CW_BAR); bar.x = 0; bar.st = nullptr;
    if (multi) bar = xcd_barrier_post((unsigned*)(F.ctl + CW_BAR), F.MISC + 8);
#define IN(k) (lo <= (k) && (k) < hi)
#define SEAM(k) do { if (IN(k) && IN((k) + 1)) xcd_barrier(bar); } while (0)
    if (IN(0)) { p0_prologue(F, args); } SEAM(0);
    if (IN(1)) { f1_proj(F, args); } SEAM(1);
    if (IN(2)) { f2_lru1(F, args); f2_attn(F, args); } SEAM(2);
    if (IN(3)) { f3_lru2(F, args); } SEAM(3);
    if (IN(5)) { f4_mix(F, args); } SEAM(5);
    if (IN(6)) { f5_out(F, args); } SEAM(6);
    if (IN(7)) { p6_router(F, args); } SEAM(7);
    if (IN(8)) { f7_moe_up(F, args); } SEAM(8);
    if (IN(9)) { f8_moe_down(F, args); } SEAM(9);
    if (IN(10)) { p9_combine(F, args); } SEAM(10);
    if (IN(11)) { f10_pl(F, args); } SEAM(11);
    if (IN(12)) { p11_final(F, args); }
#undef IN
#undef SEAM
}
extern "C" void kernel_launch(void* const* d_in, const int* in_sizes, int n_in, void* d_out, int out_size, void* d_ws, size_t ws_size, hipStream_t stream) {
    static int grid = 0;
    if (grid == 0) {
        if (n_in != 29 || in_sizes[0] != M * D || out_size != M * D || ws_size < WS_END) { fprintf(stderr, "kernel_launch: unexpected shapes/workspace (n_in %d, ws %zu)\n", n_in, ws_size); grid = -1; return; }
        int dev = 0, cus = 0, per_cu = 0;
        if (hipGetDevice(&dev) != hipSuccess || hipDeviceGetAttribute(&cus, hipDeviceAttributeMultiprocessorCount, dev) != hipSuccess) { grid = -1; return; }
        if (hipFuncSetAttribute((const void*)hyb_fwd, hipFuncAttributeMaxDynamicSharedMemorySize, LDS_BYTES) != hipSuccess) { grid = -1; return; }
        if (hipOccupancyMaxActiveBlocksPerMultiprocessor(&per_cu, (const void*)hyb_fwd, NTHREADS, LDS_BYTES) != hipSuccess || per_cu < 1) { fprintf(stderr, "kernel_launch: occupancy query says %d\n", per_cu); }
        (void)hipGetLastError();
        grid = cus;
    }
    if (grid < 0) return;
    (void)hipMemsetAsync((char*)d_ws + WS_CTL, 0, CTL_ZERO_BYTES, stream);
    Args a{};
    for (int i = 0; i < 29; ++i) a.in[i] = (const float*)d_in[i];
    a.out = (float*)d_out; a.ws = (unsigned char*)d_ws;
    if (MK_N_LAUNCHES == 1) {
        a.ph_lo = 0; a.ph_hi = NPHASE;
        hipLaunchKernelGGL(hyb_fwd, dim3(grid), dim3(NTHREADS), LDS_BYTES, stream, a);
    } else {
        for (int ph = 0; ph < NPHASE; ++ph) {
            a.ph_lo = ph; a.ph_hi = ph + 1;
            hipLaunchKernelGGL(hyb_fwd, dim3(grid), dim3(NTHREADS), LDS_BYTES, stream, a);
        }
    }
}
```

```cpp
#include <hip/hip_runtime.h>
#include <cstdio>
#include <cstdint>

#ifndef MK_N_LAUNCHES
#define MK_N_LAUNCHES 1
#endif

#define GAS __attribute__((address_space(1)))
#define LAS __attribute__((address_space(3)))
typedef unsigned short bf16;
typedef unsigned v4u __attribute__((ext_vector_type(4)));
typedef float f32x4 __attribute__((ext_vector_type(4)));
typedef GAS unsigned gu32;
#define RLX_AGENT __ATOMIC_RELAXED, __HIP_MEMORY_SCOPE_AGENT
#define LDS_WAIT() asm volatile("s_waitcnt lgkmcnt(0)" ::: "memory")
#define VM_WAIT() asm volatile("s_waitcnt vmcnt(0)" ::: "memory")

constexpr int BATCH = 2, SEQ = 8192, D = 1024, M = BATCH * SEQ;
constexpr int NH = 8, HD = 64, AW = 512, LW = 1024, NPROJ = 3584, NGATE = 2048, NIN = NPROJ + NGATE;
constexpr int PLD = 256, NE = 32, TOPK = 4, DE = 1024;
constexpr int MOE_ROWS = M * TOPK + NE * 256;
constexpr float EPS = 1e-6f;
constexpr int NWAVES = 8, NTHREADS = 512;
constexpr int NPHASE = 12;

constexpr size_t MiB = 1u << 20;
constexpr size_t WS_CTL = 0, CTL_ZERO_BYTES = 1 * MiB;
constexpr size_t WS_WLRUA = 2 * MiB, WS_WLRUX = WS_WLRUA + 256 * 1024;
constexpr size_t WS_WATTO = 3 * MiB, WS_WLRUO = 4 * MiB, WS_WOUT = 6 * MiB, WS_WPLG = 8 * MiB, WS_WPLP = 10 * MiB;
constexpr size_t WS_WIN = 12 * MiB;
constexpr size_t WS_P16 = 24 * MiB;
constexpr size_t WS_WGU = 32 * MiB;
constexpr size_t WS_WDN = 160 * MiB;
constexpr size_t WS_XN = 224 * MiB;
constexpr size_t WS_PROJ = 256 * MiB;
constexpr size_t WS_PLRAW = 432 * MiB;
constexpr size_t WS_ATT = 464 * MiB;
constexpr size_t WS_HLOC = 480 * MiB, WS_PCUM = 512 * MiB, WS_YPRE = 544 * MiB;
constexpr size_t WS_Y1 = 576 * MiB;
constexpr size_t WS_MERGED = 640 * MiB;
constexpr size_t WS_HN = 672 * MiB;
constexpr size_t WS_YROWS = 704 * MiB;
constexpr size_t WS_SMALL = 848 * MiB;
constexpr size_t WS_HMOE = 856 * MiB;
constexpr size_t WS_END = 1000 * MiB;
constexpr size_t SM_TOKE = 0, SM_TOKSLOT = 256 * 1024, SM_TOKGATE = 512 * 1024, SM_LIST = 1 * MiB  , SM_PLSTAT = 3 * MiB  ;
constexpr int CW_TMO = 0, CW_CODE = 1, CW_COUNTS = 64  , CW_BAR = 4096;

__device__ __forceinline__ int fresh_tid() { int t = (int)threadIdx.x; asm volatile("" : "+v"(t)); return t; }
__device__ __forceinline__ float bf2f(bf16 v) { return __uint_as_float(((unsigned)v) << 16); }
__device__ __forceinline__ unsigned f2bf(float f) { unsigned u = __builtin_bit_cast(unsigned, f); return (u + 0x7fffu + ((u >> 16) & 1u)) >> 16; }
__device__ __forceinline__ unsigned pk2(float lo, float hi) { return f2bf(lo) | (f2bf(hi) << 16); }
__device__ __forceinline__ float sigmoidf_(float x) { return 1.0f / (1.0f + __expf(-x)); }
__device__ __forceinline__ float logsigf_(float x) { return fminf(x, 0.f) - log1pf(__expf(-fabsf(x))); }
__device__ __forceinline__ float gelu_tanh(float x) { const float u = 0.7978845608028654f * (x + 0.044715f * x * x * x); return 0.5f * x * (1.0f + tanhf(u)); }
__device__ __forceinline__ float wave_sum(float v) {
#pragma unroll
    for (int o = 1; o < 64; o <<= 1) v += __shfl_xor(v, o);
    return v;
}

#define XB_TMO      128
#define XB_XCNT(j)  (256  + 64 * (j))
#define XB_XSUB(j)  (1280 + 64 * (j))
#define XB_XGEN(j)  (2304 + 64 * (j))
#define XB_TOP      3328
#define XB_TOPGEN   3392
#define XCD_BAR_WORDS 3456
#define XB_SPIN_CAP (1u << 18)
__device__ __forceinline__ unsigned xb_ld(unsigned* p)              { return __hip_atomic_load(p, __ATOMIC_RELAXED, __HIP_MEMORY_SCOPE_AGENT); }
__device__ __forceinline__ unsigned xb_add(unsigned* p, unsigned v) { return __hip_atomic_fetch_add(p, v, __ATOMIC_RELAXED, __HIP_MEMORY_SCOPE_AGENT); }
__device__ __forceinline__ unsigned xb_xcc_id() { return (unsigned)__builtin_amdgcn_s_getreg((3 << 11) | 20) & 0xFu; }
#define XB_SPIN(cond, bar) do { unsigned _sp = 0; while (cond) { __builtin_amdgcn_s_sleep(1); \
    if ((++_sp & 255u) == 0u) { if (xb_ld(&(bar)[XB_TMO])) break; if (_sp > XB_SPIN_CAP) { atomicAdd(&(bar)[XB_TMO], 1u); break; } } } } while (0)
struct XcdBarrier { unsigned* bar; unsigned x; volatile LAS unsigned* st; };
__device__ __forceinline__ XcdBarrier xcd_barrier_post(unsigned* bar, volatile LAS unsigned* st) {
    XcdBarrier b; b.bar = bar; b.x = xb_xcc_id(); b.st = st;
    if (threadIdx.x == 0) (void)xb_add(&bar[XB_XCNT(b.x)], 1u);
    return b;
}
__device__ __forceinline__ void xcd_barrier_complete(unsigned* bar, unsigned x, unsigned& nloc, unsigned& nx) {
    const unsigned G = gridDim.x * gridDim.y * gridDim.z;
    unsigned sum, cnt, mine, sp = 0u;
    for (;;) {
        sum = 0u; cnt = 0u; mine = 0u;
#pragma unroll
        for (unsigned j = 0; j < 16; ++j) { const unsigned c = xb_ld(&bar[XB_XCNT(j)]); sum += c; cnt += (c > 0u) ? 1u : 0u; mine = (j == x) ? c : mine; }
        if (sum == G) break;
        __builtin_amdgcn_s_sleep(1);
        if ((++sp & 255u) == 0u) { if (xb_ld(&bar[XB_TMO])) break; if (sp > XB_SPIN_CAP) { atomicAdd(&bar[XB_TMO], 1u); break; } }
    }
    nloc = mine > 0u ? mine : 1u; nx = cnt > 0u ? cnt : 1u;
}
__device__ __forceinline__ void xcd_barrier(const XcdBarrier& b) {
    asm volatile("s_waitcnt vmcnt(0)" ::: "memory");
    __syncthreads();
    if (threadIdx.x == 0) {
        unsigned* bar = b.bar;
        __builtin_amdgcn_s_waitcnt(0);
        unsigned nloc = b.st[0], nx = b.st[1];
        if (nloc == 0u) { xcd_barrier_complete(bar, b.x, nloc, nx); b.st[0] = nloc; b.st[1] = nx; }
        const unsigned old = xb_add(&bar[XB_XSUB(b.x)], 1u);
        const unsigned gen = old / nloc;
        if (old + 1u == (gen + 1u) * nloc) {
            __builtin_amdgcn_fence(__ATOMIC_RELEASE, "agent");
            asm volatile("s_waitcnt vmcnt(0)" ::: "memory");
            const unsigned og = xb_add(&bar[XB_TOP], 1u);
            const unsigned tg = og / nx;
            if (og + 1u == (tg + 1u) * nx) xb_add(&bar[XB_TOPGEN], 1u);
            else XB_SPIN(xb_ld(&bar[XB_TOPGEN]) == tg, bar);
            __builtin_amdgcn_fence(__ATOMIC_ACQUIRE, "agent");
            xb_add(&bar[XB_XGEN(b.x)], 1u);
            asm volatile("s_waitcnt vmcnt(0)" ::: "memory");
        } else {
            XB_SPIN(xb_ld(&bar[XB_XGEN(b.x)]) == gen, bar);
            __builtin_amdgcn_fence(__ATOMIC_ACQUIRE, "agent");
            asm volatile("s_waitcnt vmcnt(0)" ::: "memory");
        }
    }
    __syncthreads();
}

constexpr int RING_BYTES = 131072, LDSCTL_OFF = RING_BYTES, MISC_OFF = LDSCTL_OFF + 320, LDS_BYTES = 147456;
struct Args { const float* in[29]; float* out; unsigned char* ws; int ph_lo, ph_hi; };
struct Frame {
    LAS unsigned char* lds; volatile LAS unsigned* MISC; gu32* ctl;
    int tid, lane, wave, G, bid;
    float* out; unsigned char* ws;
};
#define WSP(T, off) ((T*)(F.ws + (off)))


namespace pg8 {
typedef unsigned short bf16_t;
typedef short bf16x8 __attribute__((ext_vector_type(8)));
typedef unsigned u32x4 __attribute__((ext_vector_type(4)));
typedef unsigned u32x2 __attribute__((ext_vector_type(2)));
typedef float f32x2 __attribute__((ext_vector_type(2)));
constexpr int BM = 256, BK = 64, HALF = 128, HTB = HALF * BK * 2, STAGE_BYTES = 8 * HTB, NXCD = 8, WGM = 8;
__host__ __device__ __forceinline__ int lds_byte(int r, int c) { const int st = (r >> 4) * 2 + (c >> 5), rr = r & 15, cc = c & 31, ob = rr * 64 + cc * 2; return st * 1024 + (ob ^ (((ob >> 9) & 1) << 5)); }
__host__ __device__ __forceinline__ void stage_rc(int b, int& R, int& C) { const int st = b / 1024, sb = b % 1024, swz = sb ^ (((sb >> 9) & 1) << 5); R = (st >> 1) * 16 + swz / 64; C = (st & 1) * 32 + (swz % 64) / 2; }
__host__ __device__ __forceinline__ int perm32(int rho) { const int n = rho >> 4, i = rho & 15; return 8 * (i >> 2) + 4 * n + (i & 3); }
struct Unit { int pm, pn, e; };
struct Gemm { const bf16_t* A; const bf16_t* Bt; int K; size_t bt_estride; };
__device__ __forceinline__ void swz_tile(int L, int nM, int nN, int& pm, int& pn) {
    const int nwg = nM * nN; int wgid = L; { const int q = nwg / NXCD, r = nwg % NXCD, xcd = wgid % NXCD, off = wgid / NXCD; wgid = (xcd < r ? xcd * (q + 1) : r * (q + 1) + (xcd - r) * q) + off; }
    const int nig = WGM * nN, gid = wgid / nig, fm = gid * WGM, gsz = (nM - fm) < WGM ? (nM - fm) : WGM;
    pm = fm + ((wgid % nig) % gsz); pn = (wgid % nig) / gsz;
}
struct StaticOrder { int nM, nN, nwg, G, c;
    __device__ void init(int M_, int N_, int G_, int c_) { nM = M_ / BM; nN = N_ / BM; nwg = nM * nN; G = G_; c = c_; }
    __device__ bool next(int i, Unit& u) const { const long L = (long)i * G + c; if (L >= nwg) return false; swz_tile((int)L, nM, nN, u.pm, u.pn); u.e = 0; return true; }
    __device__ __forceinline__ void gather_rows(const Unit&, int, int&, int&) const {}
};
struct MoeOrder { const LAS int* seg; const int* list; int nM, nN, nwg, G, c;
    __device__ void init(const LAS int* seg_, const int* list_, int N_, int G_, int c_) { seg = seg_; list = list_; nM = __builtin_amdgcn_readfirstlane(seg_[32]) / BM; nN = N_ / BM; nwg = nM * nN; G = G_; c = c_; }
    __device__ bool next(int i, Unit& u) const { const long L = (long)i * G + c; if (L >= nwg) return false; swz_tile((int)L, nM, nN, u.pm, u.pn);
        int e = 0; const int r0 = u.pm * BM;
#pragma unroll 1
        for (int q = 1; q < 32; ++q) if (__builtin_amdgcn_readfirstlane(seg[q]) <= r0) e = q;
        u.e = e; return true; }
    __device__ __forceinline__ void gather_rows(const Unit& u, int r, int& t0, int& dummy) const {
        const int l = u.pm * BM - __builtin_amdgcn_readfirstlane(seg[u.e]) + r; const int cnt = __builtin_amdgcn_readfirstlane(seg[64 + u.e]); t0 = list[(size_t)u.e * 16384 + (l < cnt ? l : 0)]; dummy = 0; }
};
__device__ __forceinline__ void glds_s(const void* sbase, unsigned voff, unsigned lds_dst) { unsigned keep;
    asm volatile("s_mov_b32 %0, m0\n\ts_mov_b32 m0, %3\n\ts_nop 0\n\tglobal_load_lds_dwordx4 %1, %2\n\ts_mov_b32 m0, %0" : "=&s"(keep) : "v"(voff), "s"(sbase), "s"(lds_dst) : "memory"); }
__device__ __forceinline__ unsigned cvt_pk_bf16(float lo, float hi) { unsigned r; asm volatile("v_cvt_pk_bf16_f32 %0, %1, %2" : "=v"(r) : "v"(lo), "v"(hi)); return r; }
__device__ __forceinline__ float fsig(float x) { return __builtin_amdgcn_rcpf(1.0f + __builtin_amdgcn_exp2f(-1.4426950408889634f * x)); }
__device__ __forceinline__ float fgelu(float x) { return x * fsig(1.5957691216057308f * (x + 0.044715f * x * x * x)); }
typedef int v8i_t __attribute__((ext_vector_type(8)));
typedef short s16x16_t __attribute__((ext_vector_type(16)));
__device__ __forceinline__ v8i_t cat8(bf16x8 a, bf16x8 b) { return __builtin_bit_cast(v8i_t, __builtin_shufflevector(a, b, 0, 1, 2, 3, 4, 5, 6, 7, 8, 9, 10, 11, 12, 13, 14, 15)); }
__device__ __forceinline__ unsigned pk4_fp8(float a, float b, float c, float d) { int w = 0; w = __builtin_amdgcn_cvt_pk_fp8_f32(a, b, w, false); w = __builtin_amdgcn_cvt_pk_fp8_f32(c, d, w, true); return (unsigned)w; }
__device__ __forceinline__ float bflo(unsigned w) { return __uint_as_float(w << 16); }
__device__ __forceinline__ float bfhi(unsigned w) { return __uint_as_float(w & 0xffff0000u); }

struct EpiProj { static constexpr bool PERM = true; bf16_t* O; const float* bmerge;
    __device__ __forceinline__ void operator()(const f32x4 (&acc)[2][2][4][2], const Unit& u, int wr, int wc, int fr, int fq) const {
        const int mode = u.pn < 2 ? 0 : (u.pn < 10 ? 1 : (u.pn < 14 ? 2 : 3));
        const int row0 = u.pm * BM + wr * 64 + fr, col0 = u.pn * BM + wc * 32 + 8 * fq;
        f32x4 bv[2][2];
#pragma unroll
        for (int bj = 0; bj < 2; ++bj)
#pragma unroll
            for (int n = 0; n < 2; ++n) bv[bj][n] = (mode == 3) ? *(const f32x4*)(bmerge + (col0 - 3584) + bj * HALF + 4 * n) : (f32x4){0.f, 0.f, 0.f, 0.f};
#pragma unroll
        for (int ai = 0; ai < 2; ++ai)
#pragma unroll
            for (int m = 0; m < 4; ++m) { bf16_t* rowp = O + (size_t)(row0 + ai * HALF + m * 16) * 5632 + col0;
#pragma unroll
                for (int bj = 0; bj < 2; ++bj) { f32x4 v0 = acc[ai][bj][m][0] + bv[bj][0], v1 = acc[ai][bj][m][1] + bv[bj][1];
                    if (mode == 0) { v0 = v0 * 0.18033688011112042f; v1 = v1 * 0.18033688011112042f; }
                    else if (mode == 2) {
#pragma unroll
                        for (int i = 0; i < 4; ++i) { v0[i] = fgelu(v0[i]); v1[i] = fgelu(v1[i]); } }
                    else if (mode == 3) {
#pragma unroll
                        for (int i = 0; i < 4; ++i) { v0[i] = fsig(v0[i]); v1[i] = fsig(v1[i]); } }
                    u32x4 w; w.x = cvt_pk_bf16(v0[0], v0[1]); w.y = cvt_pk_bf16(v0[2], v0[3]); w.z = cvt_pk_bf16(v1[0], v1[1]); w.w = cvt_pk_bf16(v1[2], v1[3]);
                    *(u32x4*)(rowp + bj * HALF) = w; } }
    }
};
struct EpiBf16 { static constexpr bool PERM = true; bf16_t* O; int ldc; const float* bias; int bias_estride; float ascale;
    __device__ __forceinline__ void operator()(const f32x4 (&acc)[2][2][4][2], const Unit& u, int wr, int wc, int fr, int fq) const {
        const int row0 = u.pm * BM + wr * 64 + fr, col0 = u.pn * BM + wc * 32 + 8 * fq;
        f32x4 bv[2][2];
#pragma unroll
        for (int bj = 0; bj < 2; ++bj)
#pragma unroll
            for (int n = 0; n < 2; ++n) bv[bj][n] = bias ? *(const f32x4*)(bias + (size_t)u.e * bias_estride + col0 + bj * HALF + 4 * n) : (f32x4){0.f, 0.f, 0.f, 0.f};
#pragma unroll
        for (int ai = 0; ai < 2; ++ai)
#pragma unroll
            for (int m = 0; m < 4; ++m) { bf16_t* rowp = O + (size_t)(row0 + ai * HALF + m * 16) * ldc + col0;
#pragma unroll
                for (int bj = 0; bj < 2; ++bj) { const f32x4 v0 = acc[ai][bj][m][0] * ascale + bv[bj][0], v1 = acc[ai][bj][m][1] * ascale + bv[bj][1];
                    u32x4 w; w.x = cvt_pk_bf16(v0[0], v0[1]); w.y = cvt_pk_bf16(v0[2], v0[3]); w.z = cvt_pk_bf16(v1[0], v1[1]); w.w = cvt_pk_bf16(v1[2], v1[3]);
                    *(u32x4*)(rowp + bj * HALF) = w; } }
    }
};
struct EpiSwiglu { static constexpr bool PERM = true; unsigned char* H; const float* bgu;
    __device__ __forceinline__ void operator()(const f32x4 (&acc)[2][2][4][2], const Unit& u, int wr, int wc, int fr, int fq) const {
        const int row0 = u.pm * BM + wr * 64 + fr, j0 = u.pn * HALF + wc * 32 + 8 * fq;
        const float* bb = bgu + (size_t)u.e * 2048 + j0;
        f32x4 bg[2], bu[2];
#pragma unroll
        for (int n = 0; n < 2; ++n) { bg[n] = *(const f32x4*)(bb + 4 * n); bu[n] = *(const f32x4*)(bb + 1024 + 4 * n); }
#pragma unroll
        for (int ai = 0; ai < 2; ++ai)
#pragma unroll
            for (int m = 0; m < 4; ++m) { float o[8];
#pragma unroll
                for (int n = 0; n < 2; ++n)
#pragma unroll
                    for (int i = 0; i < 4; ++i) { float gate = acc[ai][0][m][n][i] * 0.0625f + bg[n][i], up = acc[ai][1][m][n][i] * 0.0625f + bu[n][i];
                        gate = fminf(gate, 7.0f); up = fminf(fmaxf(up, -7.0f), 7.0f);
                        o[4 * n + i] = (up + 1.0f) * gate * fsig(1.702f * gate); }
                u32x2 w; w.x = pk4_fp8(o[0], o[1], o[2], o[3]); w.y = pk4_fp8(o[4], o[5], o[6], o[7]);
                *(u32x2*)(H + (size_t)(row0 + ai * HALF + m * 16) * 1024 + j0) = w; }
    }
};
struct EpiY1 { static constexpr bool PERM = false; float* Y1; const bf16_t* PROJ;
    __device__ __forceinline__ void operator()(const f32x4 (&acc)[2][2][4][2], const Unit& u, int wr, int wc, int fr, int fq) const {
        const int row0 = u.pm * BM + wr * 64 + fr, col0 = u.pn * BM + wc * 32 + 4 * fq;
#pragma unroll
        for (int ai = 0; ai < 2; ++ai)
#pragma unroll
            for (int m = 0; m < 4; ++m) { const size_t row = row0 + ai * HALF + m * 16;
#pragma unroll
                for (int bj = 0; bj < 2; ++bj)
#pragma unroll
                    for (int n = 0; n < 2; ++n) { const int c = col0 + bj * HALF + n * 16; const u32x2 g = *(const u32x2*)(PROJ + row * 5632 + 3584 + 1024 + c); const f32x4 a = acc[ai][bj][m][n];
                        *(f32x4*)(Y1 + row * 1024 + c) = (f32x4){a[0] * bflo(g.x), a[1] * bfhi(g.x), a[2] * bflo(g.y), a[3] * bfhi(g.y)}; } }
    }
};
struct EpiMerged { static constexpr bool PERM = false; bf16_t* MG; const float* Y1; const bf16_t* PROJ;
    __device__ __forceinline__ void operator()(const f32x4 (&acc)[2][2][4][2], const Unit& u, int wr, int wc, int fr, int fq) const {
        const int row0 = u.pm * BM + wr * 64 + fr, col0 = u.pn * BM + wc * 32 + 4 * fq;
#pragma unroll
        for (int ai = 0; ai < 2; ++ai)
#pragma unroll
            for (int m = 0; m < 4; ++m) { const size_t row = row0 + ai * HALF + m * 16;
#pragma unroll
                for (int bj = 0; bj < 2; ++bj)
#pragma unroll
                    for (int n = 0; n < 2; ++n) { const int c = col0 + bj * HALF + n * 16; const u32x2 g = *(const u32x2*)(PROJ + row * 5632 + 3584 + c); const f32x4 y = *(const f32x4*)(Y1 + row * 1024 + c); const f32x4 a = acc[ai][bj][m][n];
                        u32x2 w; w.x = cvt_pk_bf16(y[0] + a[0] * bflo(g.x), y[1] + a[1] * bfhi(g.x)); w.y = cvt_pk_bf16(y[2] + a[2] * bflo(g.y), y[3] + a[3] * bfhi(g.y));
                        *(u32x2*)(MG + row * 1024 + c) = w; } }
    }
};
struct EpiH1 { static constexpr bool PERM = false; float* H; const float* X;
    __device__ __forceinline__ void operator()(const f32x4 (&acc)[2][2][4][2], const Unit& u, int wr, int wc, int fr, int fq) const {
        const int row0 = u.pm * BM + wr * 64 + fr, col0 = u.pn * BM + wc * 32 + 4 * fq;
#pragma unroll
        for (int ai = 0; ai < 2; ++ai)
#pragma unroll
            for (int m = 0; m < 4; ++m) { const size_t row = row0 + ai * HALF + m * 16;
#pragma unroll
                for (int bj = 0; bj < 2; ++bj)
#pragma unroll
                    for (int n = 0; n < 2; ++n) { const size_t o = row * 1024 + col0 + bj * HALF + n * 16; *(f32x4*)(H + o) = *(const f32x4*)(X + o) + acc[ai][bj][m][n]; } }
    }
};
struct EpiPl { static constexpr bool PERM = false; float* H; const bf16_t* PLRAW; const float* plstat; const float* bg; const float* gpost;
    __device__ __forceinline__ void operator()(const f32x4 (&acc)[2][2][4][2], const Unit& u, int wr, int wc, int fr, int fq) const {
        const int row0 = u.pm * BM + wr * 64 + fr, col0 = u.pn * BM + wc * 32 + 4 * fq;
        f32x4 bv[2][2], gv[2][2];
#pragma unroll
        for (int bj = 0; bj < 2; ++bj)
#pragma unroll
            for (int n = 0; n < 2; ++n) { bv[bj][n] = *(const f32x4*)(bg + col0 + bj * HALF + n * 16); gv[bj][n] = *(const f32x4*)(gpost + col0 + bj * HALF + n * 16); }
#pragma unroll
        for (int ai = 0; ai < 2; ++ai)
#pragma unroll
            for (int m = 0; m < 4; ++m) { const size_t row = row0 + ai * HALF + m * 16; const float ps = plstat[row];
#pragma unroll
                for (int bj = 0; bj < 2; ++bj)
#pragma unroll
                    for (int n = 0; n < 2; ++n) { const size_t o = row * 1024 + col0 + bj * HALF + n * 16; const u32x2 p = *(const u32x2*)(PLRAW + o); const f32x4 h = *(const f32x4*)(H + o); const f32x4 a = acc[ai][bj][m][n] + bv[bj][n]; const f32x4 gp = gv[bj][n] * ps;
                        *(f32x4*)(H + o) = (f32x4){h[0] + fsig(a[0]) * bflo(p.x) * gp[0], h[1] + fsig(a[1]) * bfhi(p.x) * gp[1], h[2] + fsig(a[2]) * bflo(p.y) * gp[2], h[3] + fsig(a[3]) * bfhi(p.y) * gp[3]}; } }
    }
};

template <bool GATHER, bool FP8, class Epi, class Sched>
__device__ __forceinline__ void gemm_phase(LAS unsigned char* lds, const Gemm g, const Sched& S, const Epi& E) {
    const int tid = fresh_tid(), wid = __builtin_amdgcn_readfirstlane(tid >> 6), lane = tid & 63, wr = wid >> 2, wc = wid & 3, fr = lane & 15, fq = lane >> 4;
    const int K = g.K, nt = K / BK;
    unsigned voffA[2], voffB[2];
#pragma unroll
    for (int i = 0; i < 2; ++i) { int R, C; stage_rc(tid * 16 + i * 8192, R, C); const int Rb = Epi::PERM ? ((R & ~31) + perm32(R & 31)) : R;
        voffA[i] = (unsigned)(R * K + C) * 2u; voffB[i] = (unsigned)(Rb * K + C) * 2u; }
    const size_t kstep = (size_t)(BK * 2);
    const size_t hstep = (size_t)HALF * K * 2;
    const size_t hstepA = GATHER ? 0 : hstep;
    const size_t tstep = 2 * hstep;
    const unsigned ldsb = (unsigned)__builtin_amdgcn_readfirstlane((int)((unsigned)(uintptr_t)lds + (unsigned)wid * 1024u));
    const int aoff = lds_byte(wr * 64 + fr, fq * 8), boff = lds_byte(wc * 32 + fr, fq * 8);
#define PG8_SA(b, h) (((b) * 2 + (h)) * HTB)
#define PG8_SB(b, h) ((4 + (b) * 2 + (h)) * HTB)
#define PG8_STAGE(bufoff, gbase, voff) do { _Pragma("unroll") for (int _i = 0; _i < 2; ++_i) \
        glds_s((const void*)(gbase), (voff)[_i], ldsb + (unsigned)(bufoff) + (unsigned)(_i * 8192)); } while (0)
#define PG8_STAGE_A(bufoff, gbase, vg, h) do { _Pragma("unroll") for (int _i = 0; _i < 2; ++_i) { unsigned _vo; \
        if constexpr (GATHER) { int _t = tid; asm volatile("" : "+v"(_t)); int R_, C_; stage_rc(_t * 16 + _i * 8192, R_, C_); _vo = (((vg)[h] >> (16 * _i)) & 0xffffu) * (unsigned)(2 * K) + (unsigned)(2 * C_); } else _vo = voffA[_i]; \
        glds_s((const void*)(gbase), _vo, ldsb + (unsigned)(bufoff) + (unsigned)(_i * 8192)); } } while (0)
#define PG8_LDA(dst, b, h) do { _Pragma("unroll") for (int m = 0; m < 4; ++m) { if constexpr (FP8) { const u32x4 _l = *(const LAS u32x4*)(lds + PG8_SA(b, h) + aoff + m * 2048), _h = *(const LAS u32x4*)(lds + PG8_SA(b, h) + aoff + m * 2048 + 1024); \
        dst##8[m] = (v8i_t){(int)_l.x, (int)_l.y, (int)_l.z, (int)_l.w, (int)_h.x, (int)_h.y, (int)_h.z, (int)_h.w}; } else { _Pragma("unroll") for (int k = 0; k < 2; ++k) dst[m][k] = *(const LAS bf16x8*)(lds + PG8_SA(b, h) + aoff + m * 2048 + k * 1024); } } } while (0)
#define PG8_LDB(dst, b, h) do { _Pragma("unroll") for (int n = 0; n < 2; ++n) { if constexpr (FP8) { const u32x4 _l = *(const LAS u32x4*)(lds + PG8_SB(b, h) + boff + n * 2048), _h = *(const LAS u32x4*)(lds + PG8_SB(b, h) + boff + n * 2048 + 1024); \
        dst##8[n] = (v8i_t){(int)_l.x, (int)_l.y, (int)_l.z, (int)_l.w, (int)_h.x, (int)_h.y, (int)_h.z, (int)_h.w}; } else { _Pragma("unroll") for (int k = 0; k < 2; ++k) dst[n][k] = *(const LAS bf16x8*)(lds + PG8_SB(b, h) + boff + n * 2048 + k * 1024); } } } while (0)
#define PG8_MMA(ai, bj, At, Bt) do { __builtin_amdgcn_s_setprio(1); _Pragma("unroll") for (int m = 0; m < 4; ++m) _Pragma("unroll") for (int n = 0; n < 2; ++n) { \
        if constexpr (FP8) { acc[ai][bj][m][n] = __builtin_amdgcn_mfma_scale_f32_16x16x128_f8f6f4(Bt##8[n], At##8[m], acc[ai][bj][m][n], 0, 0, 0, 0, 0, 0); } \
        else { _Pragma("unroll") for (int k = 0; k < 2; ++k) acc[ai][bj][m][n] = __builtin_amdgcn_mfma_f32_16x16x32_bf16(Bt[n][k], At[m][k], acc[ai][bj][m][n], 0, 0, 0); } } __builtin_amdgcn_s_setprio(0); } while (0)
#define PG8_WAIT_V(n) asm volatile("s_waitcnt vmcnt(" #n ")" ::: "memory")
#define PG8_WAIT_L(n) asm volatile("s_waitcnt lgkmcnt(" #n ")" ::: "memory")
#define PG8_BAR __builtin_amdgcn_s_barrier()
#define PG8_SCHED __builtin_amdgcn_sched_barrier(0)
    Unit cur, nxt; int ui = 0;
    if (!S.next(0, cur)) return;
    f32x4 acc[2][2][4][2];
#pragma unroll
    for (int a = 0; a < 2; ++a)
#pragma unroll
        for (int b = 0; b < 2; ++b)
#pragma unroll
            for (int m = 0; m < 4; ++m)
#pragma unroll
                for (int n = 0; n < 2; ++n) acc[a][b][m][n] = (f32x4){0.f, 0.f, 0.f, 0.f};
    bf16x8 At[4][2], B0[2][2], B1[2][2]; v8i_t At8[4], B08[2], B18[2];
#define PG8_GROWS(dst, unit) do { int _t = tid; asm volatile("" : "+v"(_t)); _Pragma("unroll") for (int h = 0; h < 2; ++h) { unsigned _p = 0u; _Pragma("unroll") for (int i = 0; i < 2; ++i) { int R_, C_; stage_rc(_t * 16 + i * 8192, R_, C_); int tk, dm; S.gather_rows(unit, h * HALF + R_, tk, dm); _p |= (unsigned)tk << (16 * i); } dst[h] = _p; } } while (0)
    unsigned cvo[2] = {0u, 0u};
    if (GATHER) PG8_GROWS(cvo, cur);
    const char* cA = (const char*)g.A + (GATHER ? (size_t)0 : (size_t)cur.pm * tstep);
    const char* cB = (const char*)g.Bt + ((size_t)cur.e * g.bt_estride) * 2 + (size_t)cur.pn * tstep;
    PG8_STAGE(PG8_SB(0, 0), cB, voffB); PG8_STAGE(PG8_SB(0, 1), cB + hstep, voffB); PG8_STAGE_A(PG8_SA(0, 0), cA, cvo, 0); PG8_STAGE_A(PG8_SA(0, 1), cA + hstepA, cvo, 1);
    if (wr == 1) PG8_BAR;
    PG8_WAIT_V(2); PG8_BAR;
    PG8_STAGE(PG8_SB(1, 0), cB + kstep, voffB); PG8_STAGE_A(PG8_SA(1, 0), cA + kstep, cvo, 0); PG8_STAGE(PG8_SB(1, 1), cB + hstep + kstep, voffB);
    PG8_WAIT_V(6); PG8_BAR;
    for (;;) {
        const bool has_next = S.next(ui + 1, nxt);
        const char* nA = has_next ? (const char*)g.A + (GATHER ? (size_t)0 : (size_t)nxt.pm * tstep) : cA;
        const char* nB = has_next ? (const char*)g.Bt + ((size_t)nxt.e * g.bt_estride) * 2 + (size_t)nxt.pn * tstep : cB;
#pragma unroll 1
        for (int t = 0; t < nt; t += 2) {
            const bool last = (t == nt - 2);
            const char* a1 = cA + (size_t)(t + 1) * kstep;
            const char* a2 = last ? nA : cA + (size_t)(t + 2) * kstep; const char* b2 = last ? nB : cB + (size_t)(t + 2) * kstep;
            const char* a3 = a2 + kstep; const char* b3 = b2 + kstep;
            unsigned svo[2];
            svo[0] = cvo[0]; svo[1] = cvo[1];
            if (GATHER && last && has_next) PG8_GROWS(svo, nxt);
            PG8_LDB(B0, 0, 0); PG8_LDB(B1, 0, 1); PG8_SCHED; PG8_LDA(At, 0, 0); PG8_STAGE_A(PG8_SA(1, 1), a1 + hstepA, cvo, 1);
            PG8_WAIT_V(8); PG8_WAIT_L(0); PG8_BAR; PG8_MMA(0, 0, At, B0); PG8_MMA(0, 1, At, B1); PG8_BAR; PG8_SCHED;
            PG8_LDA(At, 0, 1); PG8_STAGE(PG8_SB(0, 0), b2, voffB); PG8_STAGE(PG8_SB(0, 1), b2 + hstep, voffB); PG8_STAGE_A(PG8_SA(0, 0), a2, svo, 0);
            PG8_WAIT_V(8); PG8_WAIT_L(0); PG8_BAR; PG8_MMA(1, 0, At, B0); PG8_MMA(1, 1, At, B1); PG8_BAR; PG8_SCHED;
            PG8_LDB(B0, 1, 0); PG8_LDB(B1, 1, 1); PG8_SCHED; PG8_LDA(At, 1, 0); PG8_STAGE_A(PG8_SA(0, 1), a2 + hstepA, svo, 1);
            PG8_WAIT_V(8); PG8_WAIT_L(0); PG8_BAR; PG8_MMA(0, 0, At, B0); PG8_MMA(0, 1, At, B1); PG8_BAR; PG8_SCHED;
            PG8_LDA(At, 1, 1); PG8_STAGE(PG8_SB(1, 0), b3, voffB); PG8_STAGE(PG8_SB(1, 1), b3 + hstep, voffB); PG8_STAGE_A(PG8_SA(1, 0), a3, svo, 0);
            PG8_WAIT_V(8); PG8_WAIT_L(0); PG8_BAR; PG8_MMA(1, 0, At, B0); PG8_MMA(1, 1, At, B1); PG8_BAR; PG8_SCHED;
        }
        if (wr == 0) PG8_BAR;
        { int frE = fr, fqE = fq; asm volatile("" : "+v"(frE), "+v"(fqE)); E(acc, cur, wr, wc, frE, fqE); }
        if (!has_next) break;
#pragma unroll
        for (int a = 0; a < 2; ++a)
#pragma unroll
            for (int b = 0; b < 2; ++b)
#pragma unroll
                for (int m = 0; m < 4; ++m)
#pragma unroll
                    for (int n = 0; n < 2; ++n) acc[a][b][m][n] = (f32x4){0.f, 0.f, 0.f, 0.f};
        cur = nxt; cA = nA; cB = nB; ++ui;
        if (GATHER) PG8_GROWS(cvo, cur);
        if (wr == 1) PG8_BAR;
    }
    PG8_WAIT_V(0);
    PG8_BAR;
#undef PG8_SA
#undef PG8_SB
#undef PG8_STAGE
#undef PG8_STAGE_A
#undef PG8_GROWS
#undef PG8_LDA
#undef PG8_LDB
#undef PG8_MMA
#undef PG8_WAIT_V
#undef PG8_WAIT_L
#undef PG8_BAR
#undef PG8_SCHED
}
}

constexpr int NG_AS = 132, NG_BS = 68;
template <bool DUAL, class ARow, class Epi>
__device__ __forceinline__ void ngemm_tile(LAS float* As, LAS float* Bs, LAS float* Bs2, const bf16* A, int lda, const ARow& arow,
                                           const bf16* Bt, int ldb, int brow0, int K, int tid, const Epi& epi) {
    const int ty = tid >> 4, tx = tid & 15;
    float acc[4][4], acc2[4][4];
#pragma unroll
    for (int i = 0; i < 4; ++i)
#pragma unroll
        for (int j = 0; j < 4; ++j) { acc[i][j] = 0.f; acc2[i][j] = 0.f; }
    const int lr = tid >> 2, lk = (tid & 3) * 8;
    const long ar = arow(lr);
    for (int k0 = 0; k0 < K; k0 += 32) {
        __syncthreads();
        {
            v4u v = (v4u){0u, 0u, 0u, 0u};
            if (ar >= 0) v = *(const v4u*)(A + (size_t)ar * lda + k0 + lk);
            const unsigned w[4] = {v.x, v.y, v.z, v.w};
#pragma unroll
            for (int j = 0; j < 4; ++j) { As[(lk + 2 * j) * NG_AS + lr] = __uint_as_float(w[j] << 16); As[(lk + 2 * j + 1) * NG_AS + lr] = __uint_as_float(w[j] & 0xffff0000u); }
        }
        if (tid < 256) {
            const v4u v = *(const v4u*)(Bt + (size_t)(brow0 + lr) * ldb + k0 + lk);
            const unsigned w[4] = {v.x, v.y, v.z, v.w};
#pragma unroll
            for (int j = 0; j < 4; ++j) { Bs[(lk + 2 * j) * NG_BS + lr] = __uint_as_float(w[j] << 16); Bs[(lk + 2 * j + 1) * NG_BS + lr] = __uint_as_float(w[j] & 0xffff0000u); }
        } else if (DUAL) {
            const int lr2 = lr - 64;
            const v4u v = *(const v4u*)(Bt + (size_t)(brow0 + 128 + lr2) * ldb + k0 + lk);
            const unsigned w[4] = {v.x, v.y, v.z, v.w};
#pragma unroll
            for (int j = 0; j < 4; ++j) { Bs2[(lk + 2 * j) * NG_BS + lr2] = __uint_as_float(w[j] << 16); Bs2[(lk + 2 * j + 1) * NG_BS + lr2] = __uint_as_float(w[j] & 0xffff0000u); }
        }
        __syncthreads();
#pragma unroll 8
        for (int k = 0; k < 32; ++k) {
            const f32x4 a = *(const LAS f32x4*)(As + k * NG_AS + ty * 4);
            const f32x4 b = *(const LAS f32x4*)(Bs + k * NG_BS + tx * 4);
#pragma unroll
            for (int i = 0; i < 4; ++i)
#pragma unroll
                for (int j = 0; j < 4; ++j) acc[i][j] += a[i] * b[j];
            if (DUAL) {
                const f32x4 b2 = *(const LAS f32x4*)(Bs2 + k * NG_BS + tx * 4);
#pragma unroll
                for (int i = 0; i < 4; ++i)
#pragma unroll
                    for (int j = 0; j < 4; ++j) acc2[i][j] += a[i] * b2[j];
            }
        }
    }
#pragma unroll
    for (int i = 0; i < 4; ++i)
#pragma unroll
        for (int j = 0; j < 4; ++j) epi(ty * 4 + i, tx * 4 + j, acc[i][j], acc2[i][j]);
}
#define NG_LDS(F) LAS float* As = (LAS float*)(F.lds); LAS float* Bs = As + 32 * NG_AS; LAS float* Bs2 = Bs + 32 * NG_BS;
struct ARowLin { long r0; __device__ __forceinline__ long operator()(int r) const { return r0 + r; } };

__device__ __forceinline__ void p0_transpose_item(const float* W, int K, int N, bf16* WT, long row_off, LAS float* scr, int kb, int nb, int lane) {
    const int k0 = 64 * kb, n0 = 32 * nb;
#pragma unroll 8
    for (int i = 0; i < 32; ++i) { const int kk = 2 * i + (lane >> 5); scr[kk * 33 + (lane & 31)] = W[(size_t)(k0 + kk) * N + n0 + (lane & 31)]; }
    LDS_WAIT(); asm volatile("" ::: "memory");
    const int c = lane & 7;
#pragma unroll
    for (int j = 0; j < 4; ++j) { const int n = (lane >> 3) + 8 * j; const LAS float* s = scr + (8 * c) * 33 + n;
        v4u o; o.x = pk2(s[0 * 33], s[1 * 33]); o.y = pk2(s[2 * 33], s[3 * 33]); o.z = pk2(s[4 * 33], s[5 * 33]); o.w = pk2(s[6 * 33], s[7 * 33]);
        *(GAS v4u*)(WT + (size_t)(row_off + n0 + n) * K + k0 + 8 * c) = o; }
    LDS_WAIT(); asm volatile("" ::: "memory");
}
__device__ __forceinline__ void p0_transpose_item_fp8(const float* W, int K, int N, unsigned char* WT, long row_off, LAS float* scr, int kb, int nb, int lane) {
    const int k0 = 64 * kb, n0 = 32 * nb;
#pragma unroll 8
    for (int i = 0; i < 32; ++i) { const int kk = 2 * i + (lane >> 5); scr[kk * 33 + (lane & 31)] = W[(size_t)(k0 + kk) * N + n0 + (lane & 31)]; }
    LDS_WAIT(); asm volatile("" ::: "memory");
    const int c = lane & 3;
#pragma unroll
    for (int j = 0; j < 2; ++j) { const int n = (lane >> 2) + 16 * j; const LAS float* sp = scr + (16 * c) * 33 + n;
        v4u o;
        o.x = pg8::pk4_fp8(16.f * sp[0 * 33], 16.f * sp[1 * 33], 16.f * sp[2 * 33], 16.f * sp[3 * 33]);
        o.y = pg8::pk4_fp8(16.f * sp[4 * 33], 16.f * sp[5 * 33], 16.f * sp[6 * 33], 16.f * sp[7 * 33]);
        o.z = pg8::pk4_fp8(16.f * sp[8 * 33], 16.f * sp[9 * 33], 16.f * sp[10 * 33], 16.f * sp[11 * 33]);
        o.w = pg8::pk4_fp8(16.f * sp[12 * 33], 16.f * sp[13 * 33], 16.f * sp[14 * 33], 16.f * sp[15 * 33]);
        *(GAS v4u*)(WT + (size_t)(row_off + n0 + n) * K + k0 + 16 * c) = o; }
    LDS_WAIT(); asm volatile("" ::: "memory");
}
__device__ __forceinline__ void rms_row_to_bf16(const float* xrow, const float* g, bf16* orow, int lane) {
    const GAS f32x4* xr = (const GAS f32x4*)xrow + lane; const GAS f32x4* gr = (const GAS f32x4*)g + lane;
    f32x4 v[4]; float s2 = 0.f;
#pragma unroll
    for (int j = 0; j < 4; ++j) { v[j] = xr[64 * j]; s2 += (v[j].x * v[j].x + v[j].y * v[j].y) + (v[j].z * v[j].z + v[j].w * v[j].w); }
    const float rstd = 1.f / sqrtf(wave_sum(s2) * (1.f / D) + EPS);
    GAS unsigned long long* o8 = (GAS unsigned long long*)orow + lane;
#pragma unroll
    for (int j = 0; j < 4; ++j) { const f32x4 gg = gr[64 * j];
        o8[64 * j] = (unsigned long long)pk2(v[j].x * rstd * gg.x, v[j].y * rstd * gg.y) | ((unsigned long long)pk2(v[j].z * rstd * gg.z, v[j].w * rstd * gg.w) << 32); }
}
__device__ __forceinline__ void p0_prologue(Frame& F, const Args& KA) {
    LAS float* scr = (LAS float*)(F.lds + F.wave * 16384);
    const int gw = F.bid * NWAVES + F.wave, NGW = F.G * NWAVES;
    constexpr int I_IN = (D / 64) * (NPROJ / 32), I_MG = (D / 64) * (NGATE / 32), I_LR = 8 * 2 * 4  ;
    constexpr int I_AO = (AW / 64) * (D / 32), I_LO = (LW / 64) * (D / 32), I_WO = (D / 64) * (D / 32), I_PG = I_WO, I_PP = (PLD / 64) * (D / 32);
    constexpr int I_GU1 = (D / 64) * (2 * DE / 32), I_DN1 = (DE / 64) * (D / 32);
    constexpr int NITEMS = I_IN + I_MG + 2 * I_LR + I_AO + I_LO + I_WO + I_PG + I_PP + NE * (I_GU1 + I_DN1);
    for (int it = gw; it < NITEMS; it += NGW) {
        int r = it;
        if (r < I_IN) { const int nblk = NPROJ / 32; p0_transpose_item(KA.in[3], D, NPROJ, WSP(bf16, WS_WIN), 0, scr, r / nblk, r % nblk, F.lane); continue; } r -= I_IN;
        if (r < I_MG) { const int nblk = NGATE / 32; p0_transpose_item(KA.in[13], D, NGATE, WSP(bf16, WS_WIN), NPROJ, scr, r / nblk, r % nblk, F.lane); continue; } r -= I_MG;
        if (r < 2 * I_LR) { const int which = r / I_LR; r %= I_LR; const int blk = r / 8, q = r % 8;
            p0_transpose_item(KA.in[which ? 8 : 6] + (size_t)blk * 128 * 128, 128, 128, WSP(bf16, which ? WS_WLRUX : WS_WLRUA) + (size_t)blk * 128 * 128, 0, scr, q / 4, q % 4, F.lane); continue; } r -= 2 * I_LR;
        if (r < I_AO) { const int nblk = D / 32; p0_transpose_item(KA.in[11], AW, D, WSP(bf16, WS_WATTO), 0, scr, r / nblk, r % nblk, F.lane); continue; } r -= I_AO;
        if (r < I_LO) { const int nblk = D / 32; p0_transpose_item(KA.in[12], LW, D, WSP(bf16, WS_WLRUO), 0, scr, r / nblk, r % nblk, F.lane); continue; } r -= I_LO;
        if (r < I_WO) { const int nblk = D / 32; p0_transpose_item(KA.in[15], D, D, WSP(bf16, WS_WOUT), 0, scr, r / nblk, r % nblk, F.lane); continue; } r -= I_WO;
        if (r < I_PG) { const int nblk = D / 32; p0_transpose_item(KA.in[24], D, D, WSP(bf16, WS_WPLG), 0, scr, r / nblk, r % nblk, F.lane); continue; } r -= I_PG;
        if (r < I_PP) { const int nblk = D / 32; p0_transpose_item(KA.in[26], PLD, D, WSP(bf16, WS_WPLP), 0, scr, r / nblk, r % nblk, F.lane); continue; } r -= I_PP;
        const int e = r / (I_GU1 + I_DN1); r %= (I_GU1 + I_DN1);
        if (r < I_GU1) { const int nblk = 2 * DE / 32, kb = r / nblk, nb = r % nblk, n0 = nb * 32;
            const int j0 = n0 % DE, isup = n0 / DE; const long dest = 256 * (j0 / 128) + (j0 % 128) + 128 * isup;
            p0_transpose_item_fp8(KA.in[19] + (size_t)e * D * 2 * DE, D, 2 * DE, WSP(unsigned char, WS_WGU) + (size_t)e * 2 * DE * D, dest - n0, scr, kb, nb, F.lane); continue; } r -= I_GU1;
        { const int nblk = D / 32; p0_transpose_item_fp8(KA.in[21] + (size_t)e * DE * D, DE, D, WSP(unsigned char, WS_WDN) + (size_t)e * D * DE, 0, scr, r / nblk, r % nblk, F.lane); }
    }
    for (int m = gw; m < M; m += NGW) rms_row_to_bf16(KA.in[0] + (size_t)m * D, KA.in[2], WSP(bf16, WS_XN) + (size_t)m * D, F.lane);
    { const size_t n4 = (size_t)M * PLD / 4; const GAS f32x4* src = (const GAS f32x4*)KA.in[1]; GAS unsigned long long* dst = (GAS unsigned long long*)WSP(bf16, WS_P16);
      for (size_t i = (size_t)F.bid * NTHREADS + F.tid; i < n4; i += (size_t)F.G * NTHREADS) { const f32x4 v = src[i]; dst[i] = (unsigned long long)pk2(v.x, v.y) | ((unsigned long long)pk2(v.z, v.w) << 32); } }
}

struct EpiProj { bf16* PROJ; const float* bmerge; int m0, n0;
    __device__ __forceinline__ void operator()(int r, int c, float a, float) const {
        const int n = n0 + c; float v;
        if (n < AW) v = a * 0.125f; else if (n < 3 * AW + LW) v = a; else if (n < NPROJ) v = gelu_tanh(a); else v = sigmoidf_(a + bmerge[n - NPROJ]);
        PROJ[(size_t)(m0 + r) * NIN + n] = (bf16)f2bf(v); } };
struct EpiPlain { bf16* O; int ldo, m0, n0;
    __device__ __forceinline__ void operator()(int r, int c, float a, float) const { O[(size_t)(m0 + r) * ldo + n0 + c] = (bf16)f2bf(a); } };
__device__ __forceinline__ void p1_proj(Frame& F, const Args& KA) {
    NG_LDS(F)
    constexpr int T1 = (M / 128) * (NIN / 64), T2 = (M / 128) * (D / 64);
    for (int t = F.bid; t < T1 + T2; t += F.G) {
        if (t < T1) { const int tm = t / (NIN / 64), tn = t % (NIN / 64);
            EpiProj E{WSP(bf16, WS_PROJ), KA.in[14], tm * 128, tn * 64};
            ngemm_tile<false>(As, Bs, Bs2, WSP(bf16, WS_XN), D, ARowLin{(long)tm * 128}, WSP(bf16, WS_WIN), D, tn * 64, D, F.tid, E);
        } else { const int u = t - T1, tm = u / (D / 64), tn = u % (D / 64);
            EpiPlain E{WSP(bf16, WS_PLRAW), D, tm * 128, tn * 64};
            ngemm_tile<false>(As, Bs, Bs2, WSP(bf16, WS_P16), PLD, ARowLin{(long)tm * 128}, WSP(bf16, WS_WPLP), PLD, tn * 64, PLD, F.tid, E);
        }
    }
}

__device__ __forceinline__ void p2_attn_naive(Frame& F, const Args& KA) {
    const bf16* PROJ = WSP(bf16, WS_PROJ); bf16* ATT = WSP(bf16, WS_ATT);
    const int gw = F.bid * NWAVES + F.wave, NGW = F.G * NWAVES;
    for (int item = gw; item < BATCH * NH * SEQ; item += NGW) {
        const int t = item % SEQ, bh = item / SEQ, h = bh % NH, b = bh / NH;
        const size_t row = (size_t)b * SEQ + t;
        const float qd = bf2f(PROJ[row * NIN + h * HD + F.lane]);
        float cum = 0.f, o = 0.f;
        for (int s = t - 1; s >= 0; --s) {
            const bf16* kr = PROJ + ((size_t)b * SEQ + s) * NIN + AW + h * HD;
            const float z = wave_sum(qd * bf2f(kr[F.lane]));
            const float vd = bf2f(kr[AW + F.lane]);
            o += __expf(logsigf_(z) + cum) * vd;
            cum += logsigf_(-z);
            if (cum < -110.f) break;
        }
        ATT[row * AW + h * HD + F.lane] = (bf16)f2bf(o);
    }
}
__device__ __forceinline__ void p2_conv_naive(Frame& F, const Args& KA) {
    const bf16* PROJ = WSP(bf16, WS_PROJ); bf16* UC = WSP(bf16, WS_HN);
    const float* cw = KA.in[4]; const float* cb = KA.in[5];
    for (size_t i = (size_t)F.bid * NTHREADS + F.tid; i < (size_t)M * LW; i += (size_t)F.G * NTHREADS) {
        const int c = (int)(i % LW); const size_t row = i / LW; const int t = (int)(row % SEQ);
        float a = cb[c];
#pragma unroll
        for (int j = 0; j < 4; ++j) { const int tt = t - 3 + j; if (tt >= 0) a += cw[j * LW + c] * bf2f(PROJ[(row - 3 + j) * NIN + 3 * AW + c]); }
        UC[i] = (bf16)f2bf(a);
    }
}
struct EpiLruA { float* AC; const float* ba; const float* lam; int m0, n0;
    __device__ __forceinline__ void operator()(int r, int c, float a, float) const { const int n = n0 + c;
        const float rr = sigmoidf_(a + ba[n]); AC[(size_t)(m0 + r) * LW + n] = 8.0f * rr * logsigf_(lam[n]); } };
struct EpiLruB { float* BC; const float* AC; const bf16* UC; const float* bx; int m0, n0;
    __device__ __forceinline__ void operator()(int r, int c, float a, float) const { const int n = n0 + c; const size_t o = (size_t)(m0 + r) * LW + n;
        const float ii = sigmoidf_(a + bx[n]); const float la = AC[o];
        BC[o] = sqrtf(-expm1f(2.0f * la)) * (ii * bf2f(UC[o])); } };
__device__ __forceinline__ void p3_lru_gates_naive(Frame& F, const Args& KA) {
    NG_LDS(F)
    constexpr int T = (M / 128) * (LW / 64);
    for (int t = F.bid; t < T; t += F.G) { const int tm = t / (LW / 64), tn = t % (LW / 64), blk = (tn * 64) / 128;
        const bf16* A = WSP(bf16, WS_HN) + blk * 128;
        { EpiLruA E{WSP(float, WS_Y1), KA.in[7], KA.in[10], tm * 128, tn * 64};
          ngemm_tile<false>(As, Bs, Bs2, A, LW, ARowLin{(long)tm * 128}, WSP(bf16, WS_WLRUA) + (size_t)blk * 128 * 128, 128, (tn * 64) % 128, 128, F.tid, E); }
        { EpiLruB E{WSP(float, WS_YROWS), WSP(float, WS_Y1), WSP(bf16, WS_HN), KA.in[9], tm * 128, tn * 64};
          ngemm_tile<false>(As, Bs, Bs2, A, LW, ARowLin{(long)tm * 128}, WSP(bf16, WS_WLRUX) + (size_t)blk * 128 * 128, 128, (tn * 64) % 128, 128, F.tid, E); }
    }
}
__device__ __forceinline__ void p3_scan_naive(Frame& F, const Args& KA) {
    const float* AC = WSP(float, WS_Y1); const float* BC = WSP(float, WS_YROWS); const bf16* PROJ = WSP(bf16, WS_PROJ); bf16* YPRE = WSP(bf16, WS_YPRE);
    const int g = F.bid * NTHREADS + F.tid;
    if (g < BATCH * LW) { const int b = g / LW, c = g % LW; float h = 0.f;
        for (int t = 0; t < SEQ; ++t) { const size_t o = ((size_t)b * SEQ + t) * LW + c;
            h = __expf(AC[o]) * h + BC[o];
            YPRE[o] = (bf16)f2bf(bf2f(PROJ[((size_t)b * SEQ + t) * NIN + 3 * AW + LW + c]) * h); } }
}
struct EpiY1 { float* Y1; const bf16* PROJ; int m0, n0;
    __device__ __forceinline__ void operator()(int r, int c, float a, float) const { const size_t row = m0 + r; const int n = n0 + c;
        Y1[row * D + n] = bf2f(PROJ[row * NIN + NPROJ + D + n]) * a; } };
struct EpiMerged { bf16* MG; const float* Y1; const bf16* PROJ; int m0, n0;
    __device__ __forceinline__ void operator()(int r, int c, float a, float) const { const size_t row = m0 + r; const int n = n0 + c;
        MG[row * D + n] = (bf16)f2bf(Y1[row * D + n] + bf2f(PROJ[row * NIN + NPROJ + n]) * a); } };
__device__ __forceinline__ void p4_mix(Frame& F, const Args& KA) {
    NG_LDS(F)
    constexpr int T = (M / 128) * (D / 64);
    for (int t = F.bid; t < T; t += F.G) { const int tm = t / (D / 64), tn = t % (D / 64);
        { EpiY1 E{WSP(float, WS_Y1), WSP(bf16, WS_PROJ), tm * 128, tn * 64};
          ngemm_tile<false>(As, Bs, Bs2, WSP(bf16, WS_YPRE), LW, ARowLin{(long)tm * 128}, WSP(bf16, WS_WLRUO), LW, tn * 64, LW, F.tid, E); }
        { EpiMerged E{WSP(bf16, WS_MERGED), WSP(float, WS_Y1), WSP(bf16, WS_PROJ), tm * 128, tn * 64};
          ngemm_tile<false>(As, Bs, Bs2, WSP(bf16, WS_ATT), AW, ARowLin{(long)tm * 128}, WSP(bf16, WS_WATTO), AW, tn * 64, AW, F.tid, E); }
    }
}
struct EpiH1 { float* H; const float* x; int m0, n0;
    __device__ __forceinline__ void operator()(int r, int c, float a, float) const { const size_t o = (size_t)(m0 + r) * D + n0 + c; H[o] = x[o] + a; } };
__device__ __forceinline__ void p5_out(Frame& F, const Args& KA) {
    NG_LDS(F)
    constexpr int T = (M / 128) * (D / 64);
    for (int t = F.bid; t < T; t += F.G) { const int tm = t / (D / 64), tn = t % (D / 64);
        EpiH1 E{F.out, KA.in[0], tm * 128, tn * 64};
        ngemm_tile<false>(As, Bs, Bs2, WSP(bf16, WS_MERGED), D, ARowLin{(long)tm * 128}, WSP(bf16, WS_WOUT), D, tn * 64, D, F.tid, E); }
}
__device__ __forceinline__ void p6_router(Frame& F, const Args& KA) {
    LAS float* xs = (LAS float*)F.lds;
    LAS float* part = xs + 16 * 1024;
    LAS int* hist = (LAS int*)(part + 8 * 16 * 32);
    LAS int* asgE = hist + 64;
    LAS int* asgR = asgE + 1024; LAS int* asgM = asgR + 1024; LAS float* asgG = (LAS float*)(asgM + 1024);
    const float* g = KA.in[16]; const float* Wr = KA.in[17]; const float* br = KA.in[18];
    const int e = F.lane & 31, half = F.lane >> 5, kb = F.wave * 128 + half * 64;
    float wreg[64];
#pragma unroll
    for (int kk = 0; kk < 64; ++kk) wreg[kk] = Wr[(size_t)(kb + kk) * NE + e];
    if (F.tid < 64) hist[F.tid] = 0;
    int nasg = 0;
    __syncthreads();
    for (int blk = F.bid; blk < M / 16; blk += F.G) {
        const int row0 = blk * 16;
#pragma unroll 1
        for (int rr = 0; rr < 2; ++rr) { const int r = F.wave * 2 + rr, m = row0 + r;
            const GAS f32x4* xr = (const GAS f32x4*)(F.out + (size_t)m * D) + F.lane; const GAS f32x4* gr = (const GAS f32x4*)g + F.lane;
            f32x4 v[4]; float s2 = 0.f;
#pragma unroll
            for (int j = 0; j < 4; ++j) { v[j] = xr[64 * j]; s2 += (v[j].x * v[j].x + v[j].y * v[j].y) + (v[j].z * v[j].z + v[j].w * v[j].w); }
            const float rstd = 1.f / sqrtf(wave_sum(s2) * (1.f / D) + EPS);
            GAS unsigned* o4 = (GAS unsigned*)(WSP(unsigned char, WS_XN) + (size_t)m * D) + F.lane;
#pragma unroll
            for (int j = 0; j < 4; ++j) { const f32x4 gg = gr[64 * j]; v[j].x *= rstd * gg.x; v[j].y *= rstd * gg.y; v[j].z *= rstd * gg.z; v[j].w *= rstd * gg.w;
                o4[64 * j] = pg8::pk4_fp8(v[j].x, v[j].y, v[j].z, v[j].w);
                *(LAS f32x4*)(xs + r * 1024 + 4 * (F.lane + 64 * j)) = v[j]; } }
        __syncthreads();
#pragma unroll 1
        for (int r = 0; r < 16; ++r) { float s = 0.f; const LAS f32x4* xp = (const LAS f32x4*)(xs + r * 1024 + kb);
#pragma unroll
            for (int q = 0; q < 16; ++q) { const f32x4 xv = xp[q]; s += xv.x * wreg[4 * q] + xv.y * wreg[4 * q + 1] + xv.z * wreg[4 * q + 2] + xv.w * wreg[4 * q + 3]; }
            s += __shfl_xor(s, 32);
            if (half == 0) part[(F.wave * 16 + r) * 32 + e] = s; }
        __syncthreads();
#pragma unroll 1
        for (int rr = 0; rr < 2; ++rr) { const int r = F.wave * 2 + rr, m = row0 + r;
            float lg = br[e];
#pragma unroll
            for (int w = 0; w < 8; ++w) lg += part[(w * 16 + r) * 32 + e];
            float tv[TOPK]; int te[TOPK];
#pragma unroll
            for (int k = 0; k < TOPK; ++k) { float bv = lg; int bi = e;
#pragma unroll
                for (int o = 1; o < 32; o <<= 1) { const float ov = __shfl_xor(bv, o); const int oi = __shfl_xor(bi, o); if (ov > bv || (ov == bv && oi < bi)) { bv = ov; bi = oi; } }
                tv[k] = bv; te[k] = bi; if (e == bi) lg = -INFINITY; }
            float den = 0.f, ex[TOPK];
#pragma unroll
            for (int k = 0; k < TOPK; ++k) { ex[k] = __expf(tv[k] - tv[0]); den += ex[k]; }
            if (F.lane < TOPK) { int ee = te[0]; float gt = ex[0];
#pragma unroll
                for (int k = 1; k < TOPK; ++k) if (F.lane == k) { ee = te[k]; gt = ex[k]; }
                const int rank = atomicAdd((int*)(hist + ee), 1);
                const int a = nasg + r * TOPK + F.lane;
                asgE[a] = ee; asgR[a] = rank; asgM[a] = m * TOPK + F.lane; asgG[a] = gt / den; } }
        nasg += 16 * TOPK;
        __syncthreads();
    }
    if (F.tid < NE) hist[32 + F.tid] = (int)atomicAdd((unsigned*)(F.ctl + CW_COUNTS + F.tid), (unsigned)hist[F.tid]);
    __syncthreads();
    int* tokE = (int*)(F.ws + WS_SMALL + SM_TOKE); int* tokS = (int*)(F.ws + WS_SMALL + SM_TOKSLOT); float* tokG = (float*)(F.ws + WS_SMALL + SM_TOKGATE);
    int* list = (int*)(F.ws + WS_SMALL + SM_LIST);
    for (int a = F.tid; a < nasg; a += NTHREADS) { const int ee = asgE[a], slot = hist[32 + ee] + asgR[a], mk = asgM[a];
        tokE[mk] = ee; tokS[mk] = slot; tokG[mk] = asgG[a]; list[(size_t)ee * M + slot] = mk / TOPK; }
}
__device__ __forceinline__ void moe_segments(Frame& F, LAS int* seg) {
    __syncthreads();
    if (F.tid == 0) { int acc = 0; for (int e = 0; e < NE; ++e) { const int c = (int)__hip_atomic_load(F.ctl + CW_COUNTS + e, RLX_AGENT); seg[e] = acc; seg[64 + e] = c; acc += (c + 255) & ~255; } seg[NE] = acc; }
    __syncthreads();
}
struct ARowGather { const int* list; int cnt; int l0; __device__ __forceinline__ long operator()(int r) const { const int l = l0 + r; return l < cnt ? (long)list[l] : -1L; } };
struct EpiSwiglu { bf16* H; const float* bgu; long row0; int j0;
    __device__ __forceinline__ void operator()(int r, int c, float ag, float au) const { const int j = j0 + c;
        float gate = ag + bgu[j], up = au + bgu[DE + j];
        gate = fminf(gate, 7.0f); up = fminf(fmaxf(up, -7.0f), 7.0f);
        const float glu = gate * sigmoidf_(gate * 1.702f);
        H[(size_t)(row0 + r) * DE + j] = (bf16)f2bf((up + 1.0f) * glu); } };
__device__ __forceinline__ void p7_moe_up(Frame& F, const Args& KA) {
    NG_LDS(F)
    LAS int* seg = (LAS int*)(F.lds + 65536);
    moe_segments(F, seg);
    const int total = seg[NE]; const int nmt = total / 128, T = nmt * (DE / 64);
    const int* list = (const int*)(F.ws + WS_SMALL + SM_LIST);
    for (int t = F.bid; t < T; t += F.G) { const int tm = t / (DE / 64), tn = t % (DE / 64); const int row0 = tm * 128;
        int e = 0;
#pragma unroll 1
        for (int q = 1; q < NE; ++q) if (seg[q] <= row0) e = q;
        const int cnt = seg[64 + e], l0 = row0 - seg[e];
        if (l0 >= cnt) continue;
        const int j0 = tn * 64; const int brow0 = 256 * (j0 / 128) + (j0 % 128);
        EpiSwiglu E{WSP(bf16, WS_HMOE), KA.in[20] + (size_t)e * 2 * DE, (long)row0, j0};
        ngemm_tile<true>(As, Bs, Bs2, WSP(bf16, WS_XN), D, ARowGather{list + (size_t)e * M, cnt, l0}, WSP(bf16, WS_WGU) + (size_t)e * 2 * DE * D, D, brow0, D, F.tid, E); }
}
struct EpiDown { bf16* Y; const float* bd; long row0; int n0;
    __device__ __forceinline__ void operator()(int r, int c, float a, float) const { Y[(size_t)(row0 + r) * D + n0 + c] = (bf16)f2bf(a + bd[n0 + c]); } };
__device__ __forceinline__ void p8_moe_down(Frame& F, const Args& KA) {
    NG_LDS(F)
    LAS int* seg = (LAS int*)(F.lds + 65536);
    moe_segments(F, seg);
    const int total = seg[NE]; const int nmt = total / 128, T = nmt * (D / 64);
    for (int t = F.bid; t < T; t += F.G) { const int tm = t / (D / 64), tn = t % (D / 64); const int row0 = tm * 128;
        int e = 0;
#pragma unroll 1
        for (int q = 1; q < NE; ++q) if (seg[q] <= row0) e = q;
        const int cnt = seg[64 + e], l0 = row0 - seg[e];
        if (l0 >= cnt) continue;
        EpiDown E{WSP(bf16, WS_YROWS), KA.in[22] + (size_t)e * D, (long)row0, tn * 64};
        ngemm_tile<false>(As, Bs, Bs2, WSP(bf16, WS_HMOE), DE, ARowLin{(long)row0}, WSP(bf16, WS_WDN) + (size_t)e * D * DE, DE, tn * 64, DE, F.tid, E); }
}
__device__ __forceinline__ void p9_combine(Frame& F, const Args& KA) {
    LAS int* seg = (LAS int*)(F.lds + 65536);
    moe_segments(F, seg);
    const int gw = F.bid * NWAVES + F.wave, NGW = F.G * NWAVES;
    const int* tokE = (const int*)(F.ws + WS_SMALL + SM_TOKE); const int* tokS = (const int*)(F.ws + WS_SMALL + SM_TOKSLOT); const float* tokG = (const float*)(F.ws + WS_SMALL + SM_TOKGATE);
    float* plstat = (float*)(F.ws + WS_SMALL + SM_PLSTAT);
    for (int m = gw; m < M; m += NGW) {
        GAS f32x4* hr = (GAS f32x4*)(F.out + (size_t)m * D) + F.lane;
        f32x4 v[4];
#pragma unroll
        for (int j = 0; j < 4; ++j) v[j] = hr[64 * j];
#pragma unroll
        for (int k = 0; k < TOPK; ++k) { const int e = tokE[m * TOPK + k]; const long row = seg[e] + tokS[m * TOPK + k]; const float gt = tokG[m * TOPK + k];
            const GAS unsigned long long* yr = (const GAS unsigned long long*)(WSP(bf16, WS_YROWS) + (size_t)row * D) + F.lane;
#pragma unroll
            for (int j = 0; j < 4; ++j) { const unsigned long long w = yr[64 * j]; const unsigned lo = (unsigned)w, hi = (unsigned)(w >> 32);
                v[j].x += gt * __uint_as_float(lo << 16); v[j].y += gt * __uint_as_float(lo & 0xffff0000u); v[j].z += gt * __uint_as_float(hi << 16); v[j].w += gt * __uint_as_float(hi & 0xffff0000u); } }
        float s2 = 0.f;
#pragma unroll
        for (int j = 0; j < 4; ++j) { hr[64 * j] = v[j]; s2 += (v[j].x * v[j].x + v[j].y * v[j].y) + (v[j].z * v[j].z + v[j].w * v[j].w); }
        const float rstd = 1.f / sqrtf(wave_sum(s2) * (1.f / D) + EPS);
        const GAS f32x4* gr = (const GAS f32x4*)KA.in[23] + F.lane;
        GAS unsigned long long* o8 = (GAS unsigned long long*)(WSP(bf16, WS_HN) + (size_t)m * D) + F.lane;
#pragma unroll
        for (int j = 0; j < 4; ++j) { const f32x4 gg = gr[64 * j];
            o8[64 * j] = (unsigned long long)pk2(v[j].x * rstd * gg.x, v[j].y * rstd * gg.y) | ((unsigned long long)pk2(v[j].z * rstd * gg.z, v[j].w * rstd * gg.w) << 32); }
        const GAS unsigned long long* pr = (const GAS unsigned long long*)(WSP(bf16, WS_PLRAW) + (size_t)m * D) + F.lane; float p2 = 0.f;
#pragma unroll
        for (int j = 0; j < 4; ++j) { const unsigned long long w = pr[64 * j]; const unsigned lo = (unsigned)w, hi = (unsigned)(w >> 32);
            const float a = __uint_as_float(lo << 16), b = __uint_as_float(lo & 0xffff0000u), c = __uint_as_float(hi << 16), d = __uint_as_float(hi & 0xffff0000u); p2 += (a * a + b * b) + (c * c + d * d); }
        const float prs = 1.f / sqrtf(wave_sum(p2) * (1.f / D) + EPS);
        if (F.lane == 0) plstat[m] = prs;
    }
}
struct EpiPl { float* H; const bf16* PLRAW; const float* plstat; const float* bg; const float* gpost; int m0, n0;
    __device__ __forceinline__ void operator()(int r, int c, float a, float) const { const size_t row = m0 + r; const int n = n0 + c; const size_t o = row * D + n;
        const float gate = sigmoidf_(a + bg[n]); const float pl = bf2f(PLRAW[o]) * plstat[row] * gpost[n]; H[o] = H[o] + gate * pl; } };
__device__ __forceinline__ void p10_pl(Frame& F, const Args& KA) {
    NG_LDS(F)
    constexpr int T = (M / 128) * (D / 64);
    for (int t = F.bid; t < T; t += F.G) { const int tm = t / (D / 64), tn = t % (D / 64);
        EpiPl E{F.out, WSP(bf16, WS_PLRAW), (const float*)(F.ws + WS_SMALL + SM_PLSTAT), KA.in[25], KA.in[27], tm * 128, tn * 64};
        ngemm_tile<false>(As, Bs, Bs2, WSP(bf16, WS_HN), D, ARowLin{(long)tm * 128}, WSP(bf16, WS_WPLG), D, tn * 64, D, F.tid, E); }
}
__device__ __forceinline__ void p11_final(Frame& F, const Args& KA) {
    const int gw = F.bid * NWAVES + F.wave, NGW = F.G * NWAVES;
    for (int m = gw; m < M; m += NGW) {
        GAS f32x4* hr = (GAS f32x4*)(F.out + (size_t)m * D) + F.lane; const GAS f32x4* gr = (const GAS f32x4*)KA.in[28] + F.lane;
        f32x4 v[4]; float s2 = 0.f;
#pragma unroll
        for (int j = 0; j < 4; ++j) { v[j] = hr[64 * j]; s2 += (v[j].x * v[j].x + v[j].y * v[j].y) + (v[j].z * v[j].z + v[j].w * v[j].w); }
        const float rstd = 1.f / sqrtf(wave_sum(s2) * (1.f / D) + EPS);
#pragma unroll
        for (int j = 0; j < 4; ++j) { const f32x4 gg = gr[64 * j]; hr[64 * j] = (f32x4){v[j].x * rstd * gg.x, v[j].y * rstd * gg.y, v[j].z * rstd * gg.z, v[j].w * rstd * gg.w}; }
    }
}


constexpr int SEG_OFF = LDSCTL_OFF + 1024;
__device__ __forceinline__ void f1_proj(Frame& F, const Args& KA) {
    { pg8::Gemm g{WSP(bf16, WS_XN), WSP(bf16, WS_WIN), D, 0}; pg8::StaticOrder S; S.init(M, NIN, F.G, F.bid);
      pg8::EpiProj E{WSP(bf16, WS_PROJ), KA.in[14]};
      pg8::gemm_phase<false, false>(F.lds, g, S, E); }
    { pg8::Gemm g{WSP(bf16, WS_P16), WSP(bf16, WS_WPLP), PLD, 0}; pg8::StaticOrder S; S.init(M, D, F.G, F.bid);
      pg8::EpiBf16 E{WSP(bf16, WS_PLRAW), D, nullptr, 0, 1.0f};
      pg8::gemm_phase<false, false>(F.lds, g, S, E); }
}
__device__ __forceinline__ void f4_mix(Frame& F, const Args& KA) {
    { pg8::Gemm g{WSP(bf16, WS_YPRE), WSP(bf16, WS_WLRUO), LW, 0}; pg8::StaticOrder S; S.init(M, D, F.G, F.bid);
      pg8::EpiY1 E{WSP(float, WS_Y1), WSP(bf16, WS_PROJ)};
      pg8::gemm_phase<false, false>(F.lds, g, S, E); }
    { pg8::Gemm g{WSP(bf16, WS_ATT), WSP(bf16, WS_WATTO), AW, 0}; pg8::StaticOrder S; S.init(M, D, F.G, F.bid);
      pg8::EpiMerged E{WSP(bf16, WS_MERGED), WSP(float, WS_Y1), WSP(bf16, WS_PROJ)};
      pg8::gemm_phase<false, false>(F.lds, g, S, E); }
}
__device__ __forceinline__ void f5_out(Frame& F, const Args& KA) {
    pg8::Gemm g{WSP(bf16, WS_MERGED), WSP(bf16, WS_WOUT), D, 0}; pg8::StaticOrder S; S.init(M, D, F.G, F.bid);
    pg8::EpiH1 E{F.out, KA.in[0]};
    pg8::gemm_phase<false, false>(F.lds, g, S, E);
}
__device__ __forceinline__ void f7_moe_up(Frame& F, const Args& KA) {
    LAS int* seg = (LAS int*)(F.lds + SEG_OFF);
    moe_segments(F, seg);
    pg8::Gemm g{WSP(bf16, WS_XN), WSP(bf16, WS_WGU), D / 2, (size_t)2 * DE * D / 2}; pg8::MoeOrder S; S.init(seg, (const int*)(F.ws + WS_SMALL + SM_LIST), 2 * DE, F.G, F.bid);
    pg8::EpiSwiglu E{WSP(unsigned char, WS_HMOE), KA.in[20]};
    pg8::gemm_phase<true, true>(F.lds, g, S, E);
}
__device__ __forceinline__ void f8_moe_down(Frame& F, const Args& KA) {
    LAS int* seg = (LAS int*)(F.lds + SEG_OFF);
    moe_segments(F, seg);
    pg8::Gemm g{WSP(bf16, WS_HMOE), WSP(bf16, WS_WDN), DE / 2, (size_t)D * DE / 2}; pg8::MoeOrder S; S.init(seg, (const int*)(F.ws + WS_SMALL + SM_LIST), D, F.G, F.bid);
    pg8::EpiBf16 E{WSP(bf16, WS_YROWS), D, KA.in[22], D, 0.0625f};
    pg8::gemm_phase<false, true>(F.lds, g, S, E);
}
__device__ __forceinline__ void f10_pl(Frame& F, const Args& KA) {
    pg8::Gemm g{WSP(bf16, WS_HN), WSP(bf16, WS_WPLG), D, 0}; pg8::StaticOrder S; S.init(M, D, F.G, F.bid);
    pg8::EpiPl E{F.out, WSP(bf16, WS_PLRAW), (const float*)(F.ws + WS_SMALL + SM_PLSTAT), KA.in[25], KA.in[27]};
    pg8::gemm_phase<false, false>(F.lds, g, S, E);
}


constexpr int LRU_CH = 512, LRU_NCH = SEQ / LRU_CH;
constexpr size_t SM_PEND = 4 * MiB - 512 * 1024, SM_HEND = SM_PEND + 128 * 1024;
constexpr int L_UA = 0, L_UASTR = 272, L_SA = 17408, L_SB = L_SA + 32768, L_QE = L_SB + 32768, L_RUN = L_QE + 4096, L_END = L_RUN + 1024;
typedef short bf16x8_t __attribute__((ext_vector_type(8)));
__device__ __forceinline__ void lru1_unit(Frame& F, const Args& KA, int unit) {
    const int b = unit >> 7, n = (unit >> 4) & 7, chunk = unit & 15;
    const int ch0 = n * 128;
    const bf16* PROJ = WSP(bf16, WS_PROJ);
    LAS unsigned char* L = F.lds;
    LAS float* SA = (LAS float*)(L + L_SA); LAS float* SB = (LAS float*)(L + L_SB); LAS float* QE = (LAS float*)(L + L_QE); LAS float* RUN = (LAS float*)(L + L_RUN);
    const int fr = F.lane & 15, fq = F.lane >> 4;
    bf16x8_t bA[4], bX[4];
    { const bf16* wa = WSP(bf16, WS_WLRUA) + (size_t)n * 128 * 128 + (size_t)(16 * F.wave + fr) * 128 + 8 * fq;
      const bf16* wx = WSP(bf16, WS_WLRUX) + (size_t)n * 128 * 128 + (size_t)(16 * F.wave + fr) * 128 + 8 * fq;
#pragma unroll
      for (int ks = 0; ks < 4; ++ks) { bA[ks] = *(const bf16x8_t*)(wa + 32 * ks); bX[ks] = *(const bf16x8_t*)(wx + 32 * ks); } }
    const int cc = ch0 + 16 * F.wave + fr;
    const float ba_c = KA.in[7][cc], bx_c = KA.in[9][cc], ls8 = 8.0f * logsigf_(KA.in[10][cc]);
    const int cs = (F.tid & 15) * 8, cr = F.tid >> 4;
    float cw[4][8], cb[8];
#pragma unroll
    for (int i = 0; i < 8; ++i) { cb[i] = KA.in[5][ch0 + cs + i];
#pragma unroll
        for (int j = 0; j < 4; ++j) cw[j][i] = KA.in[4][j * LW + ch0 + cs + i]; }
    if (F.tid < 128) { RUN[F.tid] = 1.0f; RUN[128 + F.tid] = 0.0f; }
    const int sc = F.tid & 127, sq = F.tid >> 7;
    bf16* HLOC = WSP(bf16, WS_HLOC); bf16* PCUM = WSP(bf16, WS_PCUM);
#pragma unroll 1
    for (int st = 0; st < LRU_CH / 64; ++st) {
        const int t0 = chunk * LRU_CH + st * 64;
        __syncthreads();
#pragma unroll
        for (int ps = 0; ps < 2; ++ps) { const int r = cr + 32 * ps, t = t0 + r;
            float o[8];
#pragma unroll
            for (int i = 0; i < 8; ++i) o[i] = cb[i];
#pragma unroll
            for (int j = 0; j < 4; ++j) { const int tt = t - 3 + j;
                if (tt >= 0) { const v4u u = *(const v4u*)(PROJ + ((size_t)b * SEQ + tt) * NIN + 3 * AW + ch0 + cs);
                    o[0] += cw[j][0] * pg8::bflo(u.x); o[1] += cw[j][1] * pg8::bfhi(u.x); o[2] += cw[j][2] * pg8::bflo(u.y); o[3] += cw[j][3] * pg8::bfhi(u.y);
                    o[4] += cw[j][4] * pg8::bflo(u.z); o[5] += cw[j][5] * pg8::bfhi(u.z); o[6] += cw[j][6] * pg8::bflo(u.w); o[7] += cw[j][7] * pg8::bfhi(u.w); } }
            v4u w; w.x = pk2(o[0], o[1]); w.y = pk2(o[2], o[3]); w.z = pk2(o[4], o[5]); w.w = pk2(o[6], o[7]);
            *(LAS v4u*)(L + L_UA + r * L_UASTR + cs * 2) = w; }
        __syncthreads();
        f32x4 accA[4], accX[4];
#pragma unroll
        for (int m = 0; m < 4; ++m) { accA[m] = (f32x4){0.f, 0.f, 0.f, 0.f}; accX[m] = (f32x4){0.f, 0.f, 0.f, 0.f}; }
#pragma unroll
        for (int m = 0; m < 4; ++m)
#pragma unroll
            for (int ks = 0; ks < 4; ++ks) { const bf16x8_t af = *(const LAS bf16x8_t*)(L + L_UA + (16 * m + fr) * L_UASTR + (32 * ks + 8 * fq) * 2);
                accA[m] = __builtin_amdgcn_mfma_f32_16x16x32_bf16(af, bA[ks], accA[m], 0, 0, 0);
                accX[m] = __builtin_amdgcn_mfma_f32_16x16x32_bf16(af, bX[ks], accX[m], 0, 0, 0); }
#pragma unroll
        for (int m = 0; m < 4; ++m)
#pragma unroll
            for (int i = 0; i < 4; ++i) { const int row = 16 * m + 4 * fq + i; const int cl = 16 * F.wave + fr;
                const float rr = pg8::fsig(accA[m][i] + ba_c), ii = pg8::fsig(accX[m][i] + bx_c);
                const float la = ls8 * rr, x2 = 2.0f * la;
                const float a = __expf(la);
                const float om = (x2 > -0.03f) ? -x2 * (1.0f + x2 * (0.5f + x2 * (1.0f / 6.0f))) : 1.0f - __expf(x2);
                const float uc = bf2f(*(const LAS bf16*)(L + L_UA + row * L_UASTR + cl * 2));
                SA[row * 128 + cl] = a; SB[row * 128 + cl] = sqrtf(om) * ii * uc; }
        __syncthreads();
        { float P = 1.0f, H = 0.0f;
#pragma unroll
          for (int r = 0; r < 16; ++r) { const int o = (16 * sq + r) * 128 + sc; const float a = SA[o], bb = SB[o]; H = a * H + bb; P = P * a; SA[o] = P; SB[o] = H; }
          QE[sq * 128 + sc] = P; QE[512 + sq * 128 + sc] = H; }
        __syncthreads();
        { float cp = RUN[sc], ch = RUN[128 + sc];
#pragma unroll
          for (int q = 0; q < 3; ++q) if (q < sq) { const float pe = QE[q * 128 + sc], he = QE[512 + q * 128 + sc]; ch = he + pe * ch; cp = cp * pe; }
          const size_t g0 = ((size_t)b * SEQ + t0 + 16 * sq) * LW + ch0 + sc;
#pragma unroll
          for (int r = 0; r < 16; ++r) { const int o = (16 * sq + r) * 128 + sc; const float p = SA[o], h = SB[o];
              HLOC[g0 + (size_t)r * LW] = (bf16)f2bf(h + p * ch); PCUM[g0 + (size_t)r * LW] = (bf16)f2bf(p * cp); }
          __syncthreads();
          if (sq == 3) { const float pe = QE[3 * 128 + sc], he = QE[512 + 3 * 128 + sc]; RUN[sc] = cp * pe; RUN[128 + sc] = he + pe * ch; } }
    }
    __syncthreads();
    if (F.tid < 128) { float* pend = (float*)(F.ws + WS_SMALL + SM_PEND); float* hend = (float*)(F.ws + WS_SMALL + SM_HEND);
        const size_t o = ((size_t)b * LRU_NCH + chunk) * LW + ch0 + F.tid; pend[o] = RUN[F.tid]; hend[o] = RUN[128 + F.tid]; }
    __syncthreads();
}
__device__ __forceinline__ void f2_lru1(Frame& F, const Args& KA) { for (int u = F.bid; u < BATCH * 8 * LRU_NCH; u += F.G) lru1_unit(F, KA, u); }
__device__ __forceinline__ void f3_lru2(Frame& F, const Args& KA) {
    LAS float* carry = (LAS float*)F.lds;
    const float* pend = (const float*)(F.ws + WS_SMALL + SM_PEND); const float* hend = (const float*)(F.ws + WS_SMALL + SM_HEND);
    const bf16* PROJ = WSP(bf16, WS_PROJ); const bf16* HLOC = WSP(bf16, WS_HLOC); const bf16* PCUM = WSP(bf16, WS_PCUM); bf16* YPRE = WSP(bf16, WS_YPRE);
    for (int it = F.bid; it < BATCH * LRU_NCH * 8; it += F.G) { const int part = it & 7, bc = it >> 3, b = bc / LRU_NCH, chunk = bc % LRU_NCH;
        __syncthreads();
#pragma unroll
        for (int k = 0; k < 2; ++k) { const int c = F.tid + 512 * k; float ch = 0.f;
            for (int j = 0; j < chunk; ++j) { const size_t o = ((size_t)b * LRU_NCH + j) * LW + c; ch = hend[o] + pend[o] * ch; }
            carry[c] = ch; }
        __syncthreads();
        const int c0 = (F.lane & 63) * 16;
#pragma unroll 1
        for (int rr = 0; rr < 8; ++rr) { const int t = chunk * LRU_CH + part * 64 + rr * 8 + F.wave; const size_t row = (size_t)b * SEQ + t;
#pragma unroll
            for (int hh = 0; hh < 2; ++hh) { const int c = c0 + 8 * hh;
                const v4u h = *(const v4u*)(HLOC + row * LW + c), p = *(const v4u*)(PCUM + row * LW + c), gg = *(const v4u*)(PROJ + row * NIN + 3 * AW + LW + c);
                const f32x4 ca = *(const LAS f32x4*)(carry + c), cb2 = *(const LAS f32x4*)(carry + c + 4);
                v4u o;
                o.x = pk2(pg8::bflo(gg.x) * (pg8::bflo(h.x) + pg8::bflo(p.x) * ca[0]), pg8::bfhi(gg.x) * (pg8::bfhi(h.x) + pg8::bfhi(p.x) * ca[1]));
                o.y = pk2(pg8::bflo(gg.y) * (pg8::bflo(h.y) + pg8::bflo(p.y) * ca[2]), pg8::bfhi(gg.y) * (pg8::bfhi(h.y) + pg8::bfhi(p.y) * ca[3]));
                o.z = pk2(pg8::bflo(gg.z) * (pg8::bflo(h.z) + pg8::bflo(p.z) * cb2[0]), pg8::bfhi(gg.z) * (pg8::bfhi(h.z) + pg8::bfhi(p.z) * cb2[1]));
                o.w = pk2(pg8::bflo(gg.w) * (pg8::bflo(h.w) + pg8::bflo(p.w) * cb2[2]), pg8::bfhi(gg.w) * (pg8::bfhi(h.w) + pg8::bfhi(p.w) * cb2[3]));
                *(v4u*)(YPRE + row * LW + c) = o; } }
    }
}


namespace sba {
typedef short bf16x8 __attribute__((ext_vector_type(8)));
typedef short s16x4 __attribute__((ext_vector_type(4)));
typedef float f32x16 __attribute__((ext_vector_type(16)));
typedef unsigned u32x4 __attribute__((ext_vector_type(4)));
typedef float f32x2_t __attribute__((ext_vector_type(2))); typedef __bf16 bf16x2_t __attribute__((ext_vector_type(2)));
constexpr int PITCH = NIN, SLOTB = 8192;
constexpr int A_K = 0, A_V = 2 * SLOTB, A_FLAG = 4 * SLOTB, A_OST = A_FLAG + 256, A_END = A_OST + 8 * 4096;
constexpr float CUM_DEAD = -160.0f;
__device__ __forceinline__ int crow(int r, int hi) { return (r & 3) + 8 * (r >> 2) + 4 * hi; }
__device__ __forceinline__ void glds16(const void* gsrc, unsigned lds_dst) { unsigned keep;
    asm volatile("s_mov_b32 %0, m0\n\ts_mov_b32 m0, %2\n\ts_nop 0\n\tglobal_load_lds_dwordx4 %1, off\n\ts_mov_b32 m0, %0" : "=&s"(keep) : "v"(gsrc), "s"(lds_dst) : "memory"); }
__device__ __forceinline__ unsigned cvtpk_s(float lo, float hi) { f32x2_t v = {lo, hi}; bf16x2_t b = __builtin_convertvector(v, bf16x2_t); return __builtin_bit_cast(unsigned, b); }
__device__ __forceinline__ void qkt(f32x16& p0, f32x16& p1, const LAS char* Kslot, const bf16x8* qr, int r32, int hi) {
    const LAS char* kb = Kslot + hi * 1024 + r32 * 16;
    f32x16 z = {};
#pragma unroll
    for (int d0 = 0; d0 < 4; ++d0) {
        const bf16x8 b0 = *(const LAS bf16x8*)(kb + d0 * 2048);
        const bf16x8 b1 = *(const LAS bf16x8*)(kb + d0 * 2048 + 512);
        if (d0 == 0) { p0 = __builtin_amdgcn_mfma_f32_32x32x16_bf16(b0, qr[0], z, 0, 0, 0); p1 = __builtin_amdgcn_mfma_f32_32x32x16_bf16(b1, qr[0], z, 0, 0, 0); }
        else { p0 = __builtin_amdgcn_mfma_f32_32x32x16_bf16(b0, qr[d0], p0, 0, 0, 0); p1 = __builtin_amdgcn_mfma_f32_32x32x16_bf16(b1, qr[d0], p1, 0, 0, 0); } }
}
__device__ __forceinline__ void pv(f32x16* o, int vb, bf16x8 pa0, bf16x8 pa1, bf16x8 pa2, bf16x8 pa3) {
#pragma unroll
    for (int d0 = 0; d0 < 2; ++d0) { s16x4 lo[4], hi[4];
#pragma unroll
        for (int ks = 0; ks < 4; ++ks) {
            asm volatile("ds_read_b64_tr_b16 %0,%1 offset:%c2" : "=&v"(lo[ks]) : "v"(vb), "i"(d0 * 4096 + ks * 1024) : "memory");
            asm volatile("ds_read_b64_tr_b16 %0,%1 offset:%c2" : "=&v"(hi[ks]) : "v"(vb), "i"(d0 * 4096 + ks * 1024 + 512) : "memory"); }
        asm volatile("s_waitcnt lgkmcnt(0)" ::: "memory"); __builtin_amdgcn_sched_barrier(0);
#define SBA_PK(k) (bf16x8){lo[k][0], lo[k][1], lo[k][2], lo[k][3], hi[k][0], hi[k][1], hi[k][2], hi[k][3]}
        o[d0] = __builtin_amdgcn_mfma_f32_32x32x16_bf16(pa0, SBA_PK(0), o[d0], 0, 0, 0);
        o[d0] = __builtin_amdgcn_mfma_f32_32x32x16_bf16(pa1, SBA_PK(1), o[d0], 0, 0, 0);
        o[d0] = __builtin_amdgcn_mfma_f32_32x32x16_bf16(pa2, SBA_PK(2), o[d0], 0, 0, 0);
        o[d0] = __builtin_amdgcn_mfma_f32_32x32x16_bf16(pa3, SBA_PK(3), o[d0], 0, 0, 0);
#undef SBA_PK
    }
}
__device__ __forceinline__ float block_weights(f32x16& z, float base, int hi, bool need_mask, int kv0  , int qabs) {
    float L[16];
#pragma unroll
    for (int r = 0; r < 16; ++r) { const float zz = z[r]; const float e = __builtin_amdgcn_exp2f(-fabsf(zz)); const float l = __builtin_amdgcn_logf(1.0f + e);
        L[r] = -(fmaxf(zz, 0.f) + l); z[r] = fminf(zz, 0.f) - l; }
    if (need_mask) {
#pragma unroll
        for (int r = 0; r < 16; ++r) { const int kv = kv0 + (r & 3) + 8 * (r >> 2); if (kv >= qabs) { L[r] = 0.f; z[r] = -INFINITY; } } }
    float ex[16], both[4], othm[4];
#pragma unroll
    for (int G = 0; G < 4; ++G) { ex[4 * G + 3] = 0.f; ex[4 * G + 2] = L[4 * G + 3]; ex[4 * G + 1] = ex[4 * G + 2] + L[4 * G + 2]; ex[4 * G] = ex[4 * G + 1] + L[4 * G + 1];
        const float tot = ex[4 * G] + L[4 * G];
        auto rr = __builtin_amdgcn_permlane32_swap(__float_as_uint(tot), __float_as_uint(tot), false, false);
        const float tl = __uint_as_float(rr[0]), th = __uint_as_float(rr[1]);
        both[G] = tl + th; othm[G] = hi ? 0.f : th; }
    float sfx[4]; sfx[3] = 0.f; sfx[2] = both[3]; sfx[1] = sfx[2] + both[2]; sfx[0] = sfx[1] + both[1];
#pragma unroll
    for (int G = 0; G < 4; ++G) { const float bs = base + sfx[G] + othm[G];
#pragma unroll
        for (int i = 0; i < 4; ++i) z[4 * G + i] = __builtin_amdgcn_exp2f(z[4 * G + i] + ex[4 * G + i] + bs); }
    return sfx[0] + both[0];
}
__device__ __forceinline__ void attn_unit(int b, int h, int qb, const bf16* PROJ, bf16* ATT, LAS unsigned char* lds) {
    const int tid = fresh_tid(), lane = tid & 63, r32 = lane & 31, hi = lane >> 5; const int wid = __builtin_amdgcn_readfirstlane(tid >> 6);
    const long rowbase = (long)b * SEQ; const int q0 = qb * 256;
    const bf16* Qw = PROJ + (rowbase + q0 + wid * 32) * PITCH + h * HD;
    const bf16* Kh = PROJ + rowbase * PITCH + AW + h * HD; const bf16* Vh = Kh + AW;
    const unsigned lds0 = (unsigned)(uintptr_t)lds;
    const bf16* ksrc = Kh + (long)lane * PITCH + wid * 8;
    const bf16* vsrc = Vh + (long)(16 * (wid & 3) + (lane >> 2)) * PITCH + (wid >> 2) * 32 + (lane & 3) * 8;
    const unsigned kdst = lds0 + A_K + wid * 1024, vdst = lds0 + A_V + wid * 1024;
#define SBA_DMA(t, slot) do { glds16(ksrc + (long)(t) * 64 * PITCH, (unsigned)__builtin_amdgcn_readfirstlane(kdst + (slot))); glds16(vsrc + (long)(t) * 64 * PITCH, (unsigned)__builtin_amdgcn_readfirstlane(vdst + (slot))); } while (0)
    const int vb0 = (int)(lds0 + A_V) + ((lane >> 4) & 1) * 32 + (lane & 3) * 8 + (4 * hi + ((lane & 15) >> 2)) * 64;
    volatile LAS int* wflag = (volatile LAS int*)(lds + A_FLAG);
    const int T0 = 4 * qb + 3;
    SBA_DMA(T0, 0);
    bf16x8 qr[4];
#pragma unroll
    for (int d0 = 0; d0 < 4; ++d0) qr[d0] = *(const bf16x8*)(Qw + (long)r32 * PITCH + d0 * 16 + hi * 8);
    f32x16 o[2]; o[0] = f32x16{}; o[1] = f32x16{};
    float cum = 0.f; bool dead = false;
    const int qabs = q0 + wid * 32 + r32, qmin = q0 + wid * 32, qmax = qmin + 31;
    asm volatile("s_waitcnt vmcnt(0)" ::: "memory"); __builtin_amdgcn_s_barrier();
    int slot = 0;
#pragma unroll 1
    for (int jt = T0, step = 0; jt >= 0; --jt, ++step) {
        if (jt > 0) SBA_DMA(jt - 1, slot ^ SLOTB);
        const int k0 = jt * 64;
        if (!dead && k0 < qmax) {
            const bool need_mask = (k0 + 63 >= qmin);
            f32x16 p0, p1;
            qkt(p0, p1, (const LAS char*)(lds + A_K + slot), qr, r32, hi);
            const float t1 = block_weights(p1, cum, hi, need_mask, k0 + 32 + 4 * hi, qabs);
            const float t0 = block_weights(p0, cum + t1, hi, need_mask, k0 + 4 * hi, qabs);
            cum += t0 + t1;
            u32x4 w0, w1, w2, w3;
            w0 = (u32x4){cvtpk_s(p0[0], p0[1]), cvtpk_s(p0[2], p0[3]), cvtpk_s(p0[4], p0[5]), cvtpk_s(p0[6], p0[7])};
            w1 = (u32x4){cvtpk_s(p0[8], p0[9]), cvtpk_s(p0[10], p0[11]), cvtpk_s(p0[12], p0[13]), cvtpk_s(p0[14], p0[15])};
            w2 = (u32x4){cvtpk_s(p1[0], p1[1]), cvtpk_s(p1[2], p1[3]), cvtpk_s(p1[4], p1[5]), cvtpk_s(p1[6], p1[7])};
            w3 = (u32x4){cvtpk_s(p1[8], p1[9]), cvtpk_s(p1[10], p1[11]), cvtpk_s(p1[12], p1[13]), cvtpk_s(p1[14], p1[15])};
            pv(o, vb0 + slot, __builtin_bit_cast(bf16x8, w0), __builtin_bit_cast(bf16x8, w1), __builtin_bit_cast(bf16x8, w2), __builtin_bit_cast(bf16x8, w3));
            dead = __all(cum < CUM_DEAD);
        }
        if (lane == 0) wflag[(step & 1) * 8 + wid] = dead ? 1 : 0;
        asm volatile("s_waitcnt vmcnt(0) lgkmcnt(0)" ::: "memory"); __builtin_amdgcn_s_barrier();
        int nd = 0;
#pragma unroll
        for (int w = 0; w < 8; ++w) nd += wflag[(step & 1) * 8 + w];
        if (nd == 8) break;
        slot ^= SLOTB;
    }
#undef SBA_DMA
    {   LAS bf16* stg = (LAS bf16*)(lds + A_OST) + wid * 2048;
#pragma unroll
        for (int r = 0; r < 16; ++r) { const int orow = crow(r, hi);
#pragma unroll
            for (int d0 = 0; d0 < 2; ++d0) stg[orow * 64 + d0 * 32 + r32] = (bf16)f2bf(o[d0][r]); }
        asm volatile("s_waitcnt lgkmcnt(0)" ::: "memory");
        bf16* Ow = ATT + (rowbase + q0 + wid * 32) * AW + h * HD;
#pragma unroll
        for (int i = 0; i < 4; ++i) { const int row = i * 8 + (lane >> 3), ch = lane & 7; const u32x4 v = *(const LAS u32x4*)(stg + row * 64 + ch * 8); *(u32x4*)(Ow + (long)row * AW + ch * 8) = v; } }
    asm volatile("s_waitcnt lgkmcnt(0)" ::: "memory"); __builtin_amdgcn_s_barrier();
}
}
__device__ __forceinline__ void f2_attn(Frame& F, const Args& KA) {
    for (int u = F.bid; u < BATCH * NH * 32; u += F.G) sba::attn_unit(u >> 8, (u >> 5) & 7, u & 31, WSP(bf16, WS_PROJ), WSP(bf16, WS_ATT), F.lds);
}

__global__ void __launch_bounds__(NTHREADS, 2) hyb_fwd(Args args) {
    extern __shared__ __attribute__((aligned(16))) unsigned char lds[];
    Frame F;
    F.lds = (LAS unsigned char*)lds; F.MISC = (volatile LAS unsigned*)(F.lds + MISC_OFF);
    F.tid = threadIdx.x; F.lane = F.tid & 63; F.wave = __builtin_amdgcn_readfirstlane(F.tid >> 6);
    F.G = gridDim.x; F.bid = blockIdx.x;
    F.ws = args.ws; F.ctl = (gu32*)(args.ws + WS_CTL); F.out = args.out;
    for (int u = F.tid; u < (LDS_BYTES - LDSCTL_OFF) / 4; u += NTHREADS) ((LAS unsigned*)(F.lds + LDSCTL_OFF))[u] = 0u;
    __syncthreads();
    const int lo = args.ph_lo, hi = args.ph_hi;
    const bool multi = (hi - lo) > 1;
    XcdBarrier bar; bar.bar = (unsigned*)(F.ctl + CW_BAR); bar.x = 0; bar.st = nullptr;
    if (multi) bar = xcd_barrier_post((unsigned*)(F.ctl + CW_BAR), F.MISC + 8);
#ifndef PROBE_PHASE
#define PROBE_PHASE -1
#endif
    unsigned long long pt0 = 0, ptd = 0;
#define IN(k) (lo <= (k) && (k) < hi)
#define SEAM(k) do { if (IN(k) && IN((k) + 1)) xcd_barrier(bar); F.tid = fresh_tid(); F.lane = F.tid & 63; if (PROBE_PHASE == (k)) ptd = __builtin_amdgcn_s_memrealtime() - pt0; if (PROBE_PHASE == (k) + 1) pt0 = __builtin_amdgcn_s_memrealtime(); } while (0)
    if (PROBE_PHASE == 0) pt0 = __builtin_amdgcn_s_memrealtime();
    if (IN(0)) { p0_prologue(F, args); } SEAM(0);
    if (IN(1)) { f1_proj(F, args); } SEAM(1);
    if (IN(2)) { f2_lru1(F, args); f2_attn(F, args); } SEAM(2);
    if (IN(3)) { f3_lru2(F, args); } SEAM(3);
    if (IN(4)) { f4_mix(F, args); } SEAM(4);
    if (IN(5)) { f5_out(F, args); } SEAM(5);
    if (IN(6)) { p6_router(F, args); } SEAM(6);
    if (IN(7)) { f7_moe_up(F, args); } SEAM(7);
    if (IN(8)) { f8_moe_down(F, args); } SEAM(8);
    if (IN(9)) { p9_combine(F, args); } SEAM(9);
    if (IN(10)) { f10_pl(F, args); } SEAM(10);
    if (IN(11)) { p11_final(F, args); }
    if (PROBE_PHASE == 11) ptd = __builtin_amdgcn_s_memrealtime() - pt0;
    if (PROBE_PHASE >= 0) { const unsigned long long ts = __builtin_amdgcn_s_memrealtime(); while (__builtin_amdgcn_s_memrealtime() - ts < ptd) __builtin_amdgcn_s_sleep(8); }
#undef IN
#undef SEAM
}
extern "C" void kernel_launch(void* const* d_in, const int* in_sizes, int n_in, void* d_out, int out_size, void* d_ws, size_t ws_size, hipStream_t stream) {
    static int grid = 0;
    if (grid == 0) {
        if (n_in != 29 || in_sizes[0] != M * D || out_size != M * D || ws_size < WS_END) { fprintf(stderr, "kernel_launch: unexpected shapes/workspace (n_in %d, ws %zu)\n", n_in, ws_size); grid = -1; return; }
        int dev = 0, cus = 0, per_cu = 0;
        if (hipGetDevice(&dev) != hipSuccess || hipDeviceGetAttribute(&cus, hipDeviceAttributeMultiprocessorCount, dev) != hipSuccess) { grid = -1; return; }
        if (hipFuncSetAttribute((const void*)hyb_fwd, hipFuncAttributeMaxDynamicSharedMemorySize, LDS_BYTES) != hipSuccess) { grid = -1; return; }
        if (hipOccupancyMaxActiveBlocksPerMultiprocessor(&per_cu, (const void*)hyb_fwd, NTHREADS, LDS_BYTES) != hipSuccess || per_cu < 1) { fprintf(stderr, "kernel_launch: occupancy query says %d\n", per_cu); }
        (void)hipGetLastError();
        grid = cus;
    }
    if (grid < 0) return;
    (void)hipMemsetAsync((char*)d_ws + WS_CTL, 0, CTL_ZERO_BYTES, stream);
    Args a{};
    for (int i = 0; i < 29; ++i) a.in[i] = (const float*)d_in[i];
    a.out = (float*)d_out; a.ws = (unsigned char*)d_ws;
    if (MK_N_LAUNCHES == 1) {
        a.ph_lo = 0; a.ph_hi = NPHASE;
        hipLaunchKernelGGL(hyb_fwd, dim3(grid), dim3(NTHREADS), LDS_BYTES, stream, a);
    } else {
        for (int ph = 0; ph < NPHASE; ++ph) {
            a.ph_lo = ph; a.ph_hi = ph + 1;
            hipLaunchKernelGGL(hyb_fwd, dim3(grid), dim3(NTHREADS), LDS_BYTES, stream, a);
        }
    }
}
```
